# Optimizing an MI355X kernel written in HIP

```python
import math
import jax
import jax.numpy as jnp
from jax import lax
import numpy as np

D_MODEL = 1024
BATCH = 4
SEQ = 8192
DEPTH = 4

GRID_W = 64
CTX_LEN = 256
N_MIXERS = 2
ATTN_MIXER = 0
SGU_MIXER = 1
N_ATTN_LAYERS = (DEPTH + 1) // 2
N_SGU_LAYERS = DEPTH // 2
N_MOD = 6
EPS = 1e-6

DA_HEADS = 8
DA_HEAD_DIM = 64
DA_QK_WIDTH = DA_HEADS * 2 * DA_HEAD_DIM
DA_V_WIDTH = DA_HEADS * 2 * DA_HEAD_DIM
Q_BLOCK = 128
ROPE_THETA = 10000.0
ROPE_AXIS_DIM = DA_HEAD_DIM // 2
ROPE_PAIRS = ROPE_AXIS_DIM // 2

SGU_WIDTH = 4 * D_MODEL
SGU_HALF = SGU_WIDTH // 2
SGU_GROUPS = 8
CHUNK = 128

MLP_HIDDEN = 4 * D_MODEL

kernel_name = 'hybrid_diffattn_sgu_dit'


def rms_norm(x, g):
    xf = x.astype(jnp.float32)
    y = xf * lax.rsqrt(jnp.mean(xf * xf, axis=-1, keepdims=True) + EPS)
    return (y * g.astype(jnp.float32)).astype(x.dtype)


def layer_norm(x, g, b):
    xf = x.astype(jnp.float32)
    mu = jnp.mean(xf, axis=-1, keepdims=True)
    var = jnp.mean(jnp.square(xf - mu), axis=-1, keepdims=True)
    y = (xf - mu) * lax.rsqrt(var + EPS)
    return (y * g.astype(jnp.float32) + b.astype(jnp.float32)).astype(x.dtype)


def modulate(h, shift, scale):
    return h * (1 + scale) + shift


def axial_rope_tables(n_rows):
    rows = jnp.broadcast_to(jnp.arange(n_rows, dtype=jnp.float32)[:, None], (n_rows, GRID_W)).reshape(-1)
    cols = jnp.broadcast_to(jnp.arange(GRID_W, dtype=jnp.float32)[None, :], (n_rows, GRID_W)).reshape(-1)
    inv_freq = ROPE_THETA ** (-jnp.arange(ROPE_PAIRS, dtype=jnp.float32) / ROPE_PAIRS)
    ang_r = rows[:, None] * inv_freq
    ang_c = cols[:, None] * inv_freq
    ang = jnp.concatenate([ang_r, ang_r, ang_c, ang_c], axis=-1)
    return jnp.cos(ang), jnp.sin(ang)


def apply_rope(x, cos, sin):
    xs = x.reshape(x.shape[:-1] + (2, 2, ROPE_PAIRS))
    rot = jnp.stack([-xs[..., 1, :], xs[..., 0, :]], axis=-2).reshape(x.shape)
    c = cos[:, None, None, :].astype(x.dtype)
    s = sin[:, None, None, :].astype(x.dtype)
    return x * c + rot * s


def diff_attend(q, k, v, lam):
    s = jnp.einsum('bqhmd,bkhmd->mbhqk', q, k).astype(jnp.float32) * (DA_HEAD_DIM ** -0.5)
    p = jax.nn.softmax(s, axis=-1)
    a = (p[0] - lam * p[1]).astype(v.dtype)
    return jnp.einsum('bhqk,bkhe->bqhe', a, v)


def diff_heads_out(o, subln_g, lam_init, w_o):
    o = rms_norm(o, subln_g) * (1 - lam_init)
    return o.reshape(o.shape[0], o.shape[1], DA_V_WIDTH) @ w_o


def differential_attention(h_lat, h_ctx, w_qkv, w_o, lam_params, subln_g, lam_init, cos, sin, ctx_queries):
    B, S, _ = h_lat.shape
    C = h_ctx.shape[1]
    qkv = h_lat @ w_qkv
    q = apply_rope(qkv[..., :DA_QK_WIDTH].reshape(B, S, DA_HEADS, 2, DA_HEAD_DIM), cos, sin)
    k = apply_rope(qkv[..., DA_QK_WIDTH:2 * DA_QK_WIDTH].reshape(B, S, DA_HEADS, 2, DA_HEAD_DIM), cos, sin)
    v = qkv[..., 2 * DA_QK_WIDTH:].reshape(B, S, DA_HEADS, 2 * DA_HEAD_DIM)
    kv_c = h_ctx @ w_qkv[:, DA_QK_WIDTH:]
    k_c = kv_c[..., :DA_QK_WIDTH].reshape(B, C, DA_HEADS, 2, DA_HEAD_DIM)
    v_c = kv_c[..., DA_QK_WIDTH:].reshape(B, C, DA_HEADS, 2 * DA_HEAD_DIM)
    lp = lam_params.astype(jnp.float32)
    lam = jnp.exp(jnp.sum(lp[0] * lp[1])) - jnp.exp(jnp.sum(lp[2] * lp[3])) + lam_init
    k_all = jnp.concatenate([k_c, k], axis=1)
    v_all = jnp.concatenate([v_c, v], axis=1)
    n_blk = S // Q_BLOCK
    q_blocks = jnp.moveaxis(q.reshape(B, n_blk, Q_BLOCK, DA_HEADS, 2, DA_HEAD_DIM), 1, 0)
    o = lax.map(lambda qb: diff_attend(qb, k_all, v_all, lam), q_blocks)
    o = jnp.moveaxis(o, 0, 1).reshape(B, S, DA_HEADS, 2 * DA_HEAD_DIM)
    y_lat = diff_heads_out(o, subln_g, lam_init, w_o)
    y_ctx = None
    if ctx_queries:
        q_c = (h_ctx @ w_qkv[:, :DA_QK_WIDTH]).reshape(B, C, DA_HEADS, 2, DA_HEAD_DIM)
        y_ctx = diff_heads_out(diff_attend(q_c, k_c, v_c, lam), subln_g, lam_init, w_o)
    return y_lat, y_ctx


def spatial_gating_mix(h, w_in, b_in, ln_g, ln_b, w_s, b_s, w_out):
    B, N, _ = h.shape
    z = jax.nn.gelu(h @ w_in + b_in, approximate=False)
    u = z[..., :SGU_HALF]
    v = layer_norm(z[..., SGU_HALF:], ln_g, ln_b)
    v = v.reshape(B, N // CHUNK, CHUNK, SGU_GROUPS, SGU_HALF // SGU_GROUPS)
    sv = jnp.einsum('gpq,bnqgc->bnpgc', w_s, v) + b_s.T[:, :, None]
    return (u * sv.reshape(B, N, SGU_HALF)) @ w_out


def channel_mlp(h, w1, w2):
    return jnp.square(jax.nn.relu(h @ w1)) @ w2


def setup_inputs(seed: int = 0) -> dict:
    key = jax.random.key(seed)
    ks = jax.random.split(key, 24)
    f32 = jnp.float32
    D = D_MODEL

    def nrm(k, shape, scale):
        return jax.random.normal(k, shape, f32) * scale

    return {
        'x': nrm(ks[0], (BATCH, SEQ, D), 1.0),
        'c': nrm(ks[1], (BATCH, D), 1.0),
        'ctx': nrm(ks[2], (BATCH, CTX_LEN, D), 1.0),
        'c_ctx': nrm(ks[3], (D,), 1.0),
        'w_mod': nrm(ks[4], (DEPTH, D, N_MOD * D), 0.5 * D ** -0.5),
        'b_mod': nrm(ks[5], (DEPTH, N_MOD * D), 0.02),
        'norm_g': 1.0 + nrm(ks[6], (DEPTH, 4, D), 0.02),
        'da_w_qkv': nrm(ks[7], (N_ATTN_LAYERS, D, 2 * DA_QK_WIDTH + DA_V_WIDTH), D ** -0.5),
        'da_w_o': nrm(ks[8], (N_ATTN_LAYERS, DA_V_WIDTH, D), DA_V_WIDTH ** -0.5),
        'da_lambda': nrm(ks[9], (N_ATTN_LAYERS, 4, DA_HEAD_DIM), 0.1),
        'da_subln_g': 1.0 + nrm(ks[10], (N_ATTN_LAYERS, 2 * DA_HEAD_DIM), 0.02),
        'sgu_w_in': nrm(ks[11], (N_SGU_LAYERS, D, SGU_WIDTH), D ** -0.5),
        'sgu_b_in': nrm(ks[12], (N_SGU_LAYERS, SGU_WIDTH), 0.02),
        'sgu_ln_g': 1.0 + nrm(ks[13], (N_SGU_LAYERS, SGU_HALF), 0.02),
        'sgu_ln_b': nrm(ks[14], (N_SGU_LAYERS, SGU_HALF), 0.02),
        'sgu_w_s': nrm(ks[15], (N_SGU_LAYERS, SGU_GROUPS, CHUNK, CHUNK), CHUNK ** -0.5),
        'sgu_b_s': 1.0 + nrm(ks[16], (N_SGU_LAYERS, SGU_GROUPS, CHUNK), 0.02),
        'sgu_w_out': nrm(ks[17], (N_SGU_LAYERS, SGU_HALF, D), SGU_HALF ** -0.5),
        'mlp_w1': nrm(ks[18], (DEPTH, D, MLP_HIDDEN), D ** -0.5),
        'mlp_w2': nrm(ks[19], (DEPTH, MLP_HIDDEN, D), MLP_HIDDEN ** -0.5),
    }


def reference(x, c, ctx, c_ctx, w_mod, b_mod, norm_g, da_w_qkv, da_w_o, da_lambda, da_subln_g,
              sgu_w_in, sgu_b_in, sgu_ln_g, sgu_ln_b, sgu_w_s, sgu_b_s, sgu_w_out, mlp_w1, mlp_w2):
    B, S, D = x.shape
    ROWS = S // GRID_W
    cos, sin = axial_rope_tables(ROWS)
    silu_c = jax.nn.silu(c)
    silu_cc = jax.nn.silu(c_ctx)
    h_ctx = ctx
    for i in range(DEPTH):
        mixer = i % N_MIXERS
        j = i // N_MIXERS
        ctx_after = any((l % N_MIXERS) == ATTN_MIXER for l in range(i + 1, DEPTH))
        ctx_in = (mixer == ATTN_MIXER) or ctx_after
        mod = (silu_c @ w_mod[i] + b_mod[i]).reshape(B, N_MOD, 1, D)
        sh_a, sc_a, gt_a, sh_f, sc_f, gt_f = [mod[:, m] for m in range(N_MOD)]
        g_pre_a, g_post_a, g_pre_f, g_post_f = [norm_g[i, m] for m in range(4)]
        a_lat = modulate(rms_norm(x, g_pre_a), sh_a, sc_a)
        if ctx_in:
            mod_c = (silu_cc @ w_mod[i] + b_mod[i]).reshape(N_MOD, 1, D)
            csh_a, csc_a, cgt_a, csh_f, csc_f, cgt_f = [mod_c[m] for m in range(N_MOD)]
            a_ctx = modulate(rms_norm(h_ctx, g_pre_a), csh_a, csc_a)
        if mixer == ATTN_MIXER:
            lam_init = 0.8 - 0.6 * math.exp(-0.3 * i)
            y_lat, y_ctx = differential_attention(a_lat, a_ctx, da_w_qkv[j], da_w_o[j], da_lambda[j],
                                                  da_subln_g[j], lam_init, cos, sin, ctx_after)
        else:
            y_lat = spatial_gating_mix(a_lat, sgu_w_in[j], sgu_b_in[j], sgu_ln_g[j], sgu_ln_b[j],
                                       sgu_w_s[j], sgu_b_s[j], sgu_w_out[j])
            y_ctx = None
            if ctx_after:
                y_ctx = spatial_gating_mix(a_ctx, sgu_w_in[j], sgu_b_in[j], sgu_ln_g[j], sgu_ln_b[j],
                                           sgu_w_s[j], sgu_b_s[j], sgu_w_out[j])
        x = x + gt_a * rms_norm(y_lat, g_post_a)
        f_lat = channel_mlp(modulate(rms_norm(x, g_pre_f), sh_f, sc_f), mlp_w1[i], mlp_w2[i])
        x = x + gt_f * rms_norm(f_lat, g_post_f)
        if ctx_after:
            h_ctx = h_ctx + cgt_a * rms_norm(y_ctx, g_post_a)
            f_ctx = channel_mlp(modulate(rms_norm(h_ctx, g_pre_f), csh_f, csc_f), mlp_w1[i], mlp_w2[i])
            h_ctx = h_ctx + cgt_f * rms_norm(f_ctx, g_post_f)
    return x
```

```cpp
#include <hip/hip_runtime.h>
#include <hip/hip_cooperative_groups.h>
#include <cstdio>
#include <cstdint>
namespace cg = cooperative_groups;

#define LAS __attribute__((address_space(3)))
typedef unsigned short bf16_t;
typedef short bf16x8 __attribute__((ext_vector_type(8)));
typedef short s16x4 __attribute__((ext_vector_type(4)));
typedef float f32x4 __attribute__((ext_vector_type(4)));
typedef float f32x2 __attribute__((ext_vector_type(2)));
typedef float f32x16 __attribute__((ext_vector_type(16)));
typedef unsigned u32x4 __attribute__((ext_vector_type(4)));
typedef unsigned u32x2 __attribute__((ext_vector_type(2)));
typedef __bf16 bf16x2_t __attribute__((ext_vector_type(2)));

constexpr int D = 1024, NB = 4, SEQ = 8192, CTX = 256, MLAT = NB * SEQ, MCTX = NB * CTX, MALL = MLAT + MCTX;
constexpr int NMOD = 6, QKVW = 3072, FF = 4096, SGUW = 4096, SGUH = 2048;
constexpr float EPS = 1e-6f;
constexpr float QSCALE = 0.125f * 1.4426950408889634f;

constexpr size_t MiB = 1u << 20;
constexpr size_t WS_MOD = 1 * MiB;
constexpr size_t WS_ROPE = 1 * MiB + 512 * 1024;
constexpr size_t WS_WS = 2 * MiB;
constexpr size_t WS_LNST = 2 * MiB + 512 * 1024;
constexpr size_t WS_WQKV = 3 * MiB;
constexpr size_t WS_WO = 15 * MiB;
constexpr size_t WS_WIN = 19 * MiB;
constexpr size_t WS_WOUT = 35 * MiB;
constexpr size_t WS_W1 = 43 * MiB;
constexpr size_t WS_W2 = 75 * MiB;
constexpr size_t WS_XCTX = 107 * MiB;
constexpr size_t WS_A = 111 * MiB;
constexpr size_t WS_Y = 177 * MiB;
constexpr size_t WS_BIG = 243 * MiB;
constexpr size_t WS_END = 507 * MiB;

__device__ __forceinline__ unsigned cvt_pk_bf16(float lo, float hi) { f32x2 v = {lo, hi}; bf16x2_t b = __builtin_convertvector(v, bf16x2_t); return __builtin_bit_cast(unsigned, b); }
__device__ __forceinline__ float bf_lo(unsigned u) { return __uint_as_float(u << 16); }
__device__ __forceinline__ float bf_hi(unsigned u) { return __uint_as_float(u & 0xffff0000u); }
__device__ __forceinline__ float wave_sum(float v) {
#pragma unroll
    for (int o = 1; o < 64; o <<= 1) v += __shfl_xor(v, o);
    return v;
}

__device__ __forceinline__ int launder_s(int v) { asm volatile("" : "+s"(v)); return v; }
namespace pg8 {
constexpr int BM = 256, BK = 64, HALF = 128, HTB = HALF * BK * 2, STAGE_BYTES = 8 * HTB, NXCD = 8, WGM = 4;
__host__ __device__ __forceinline__ int lds_byte(int r, int c) { const int st = (r >> 4) * 2 + (c >> 5), rr = r & 15, cc = c & 31, ob = rr * 64 + cc * 2; return st * 1024 + (ob ^ (((ob >> 9) & 1) << 5)); }
__host__ __device__ __forceinline__ void stage_rc(int b, int& R, int& C) { const int st = b / 1024, sb = b % 1024, swz = sb ^ (((sb >> 9) & 1) << 5); R = (st >> 1) * 16 + swz / 64; C = (st & 1) * 32 + (swz % 64) / 2; }
__host__ __device__ __forceinline__ int perm32(int rho) { const int n = rho >> 4, i = rho & 15; return 8 * (i >> 2) + 4 * n + (i & 3); }

struct Unit { int pm, pn; };
struct Gemm { const bf16_t* A; const bf16_t* Bt; int M, N, K, lda; };

struct StaticOrder {
    int nM, nN, nwg, G, c;
    __device__ void init(int M, int N, int G_, int c_) { nM = M / BM; nN = N / BM; nwg = nM * nN; G = G_; c = c_; }
    __device__ bool next(int i, Unit& u) const {
        const long L = (long)i * G + c; if (L >= nwg) return false;
        int wgid = (int)L; { const int q = nwg / NXCD, r = nwg % NXCD, xcd = wgid % NXCD, off = wgid / NXCD; wgid = (xcd < r ? xcd * (q + 1) : r * (q + 1) + (xcd - r) * q) + off; }
        const int nig = WGM * nN, gid = wgid / nig, fm = gid * WGM, gsz = (nM - fm) < WGM ? (nM - fm) : WGM;
        u.pm = fm + ((wgid % nig) % gsz); u.pn = (wgid % nig) / gsz; return true;
    }
};

__device__ __forceinline__ f32x2 gelu_pk(f32x2 v) {
    const f32x2 av = __builtin_elementwise_abs(v), d = av * 0.2316418882f + 1.0f;
    f32x2 t; t.x = __builtin_amdgcn_rcpf(d.x); t.y = __builtin_amdgcn_rcpf(d.y);
    f32x2 q = t * 0.5307027145f + (-0.7265760135f); q = q * t + 0.7107068705f; q = q * t + (-0.142248368f); q = q * t + 0.127414796f; q = q * t;
    const f32x2 s = (v * v) * (-0.72134752044f);
    f32x2 e; e.x = __builtin_amdgcn_exp2f(s.x); e.y = __builtin_amdgcn_exp2f(s.y);
    const f32x2 m = v * (q * e), r = v - m;
    f32x2 o; o.x = v.x < 0.f ? m.x : r.x; o.y = v.y < 0.f ? m.y : r.y; return o;
}

template <int ACT  > struct EpiBf16 {
    static constexpr bool PERM = true;
    bf16_t* O; int ldc; const float* bias;
    __device__ __forceinline__ void operator()(const f32x4 (&acc)[2][2][4][2], const Unit& u, int wr, int wc, int fr, int fq) const {
        const int row0 = u.pm * BM + wr * 64 + fr; const int col0 = u.pn * BM + wc * 32 + 8 * fq;
        f32x4 bv[2][2];
#pragma unroll
        for (int bj = 0; bj < 2; ++bj)
#pragma unroll
            for (int n = 0; n < 2; ++n) bv[bj][n] = bias ? *(const f32x4*)(bias + col0 + bj * HALF + 4 * n) : (f32x4){0.f, 0.f, 0.f, 0.f};
#pragma unroll
        for (int ai = 0; ai < 2; ++ai)
#pragma unroll
            for (int m = 0; m < 4; ++m) { bf16_t* rowp = O + (size_t)(row0 + ai * HALF + m * 16) * ldc + col0;
#pragma unroll
                for (int bj = 0; bj < 2; ++bj) { f32x4 v0 = acc[ai][bj][m][0] + bv[bj][0], v1 = acc[ai][bj][m][1] + bv[bj][1];
                    if (ACT == 1) { f32x2 a = gelu_pk((f32x2){v0[0], v0[1]}), b = gelu_pk((f32x2){v0[2], v0[3]}), c = gelu_pk((f32x2){v1[0], v1[1]}), d = gelu_pk((f32x2){v1[2], v1[3]});
                        v0 = (f32x4){a.x, a.y, b.x, b.y}; v1 = (f32x4){c.x, c.y, d.x, d.y}; }
                    if (ACT == 2) {
#pragma unroll
                        for (int e = 0; e < 4; ++e) { const float a = fmaxf(v0[e], 0.f), b = fmaxf(v1[e], 0.f); v0[e] = a * a; v1[e] = b * b; } }
                    u32x4 w; w.x = cvt_pk_bf16(v0[0], v0[1]); w.y = cvt_pk_bf16(v0[2], v0[3]); w.z = cvt_pk_bf16(v1[0], v1[1]); w.w = cvt_pk_bf16(v1[2], v1[3]);
                    *(u32x4*)(rowp + bj * HALF) = w; } }
    }
};
struct EpiQKV {
    static constexpr bool PERM = true;
    bf16_t* O; const float* rope;
    __device__ __forceinline__ void operator()(const f32x4 (&acc)[2][2][4][2], const Unit& u, int wr, int wc, int fr, int fq) const {
        const int row0 = u.pm * BM + wr * 64 + fr; const int col0 = u.pn * BM + wc * 32 + 8 * fq;
        const bool do_rope = (u.pn < 8) && (u.pm < MLAT / BM);
        const float sc = (u.pn < 4) ? QSCALE : 1.f;
#pragma unroll
        for (int ai = 0; ai < 2; ++ai)
#pragma unroll
            for (int m = 0; m < 4; ++m) { const int row = row0 + ai * HALF + m * 16; bf16_t* rowp = O + (size_t)row * QKVW + col0;
                f32x4 cs0 = {1.f, 0.f, 1.f, 0.f}, cs1 = {1.f, 0.f, 1.f, 0.f};
                if (do_rope) { const int s = row & (SEQ - 1); const int pos = (wc & 1) ? (s & 63) : (s >> 6); const float* t = rope + (pos * 16 + 4 * fq) * 2; cs0 = *(const f32x4*)t; cs1 = *(const f32x4*)(t + 4); }
#pragma unroll
                for (int bj = 0; bj < 2; ++bj) { const f32x4 v0 = acc[ai][bj][m][0], v1 = acc[ai][bj][m][1]; f32x4 o0, o1;
                    o0[0] = v0[0] * cs0[0] - v0[1] * cs0[1]; o0[1] = v0[1] * cs0[0] + v0[0] * cs0[1];
                    o0[2] = v0[2] * cs0[2] - v0[3] * cs0[3]; o0[3] = v0[3] * cs0[2] + v0[2] * cs0[3];
                    o1[0] = v1[0] * cs1[0] - v1[1] * cs1[1]; o1[1] = v1[1] * cs1[0] + v1[0] * cs1[1];
                    o1[2] = v1[2] * cs1[2] - v1[3] * cs1[3]; o1[3] = v1[3] * cs1[2] + v1[2] * cs1[3];
                    o0 = o0 * sc; o1 = o1 * sc;
                    u32x4 w; w.x = cvt_pk_bf16(o0[0], o0[1]); w.y = cvt_pk_bf16(o0[2], o0[3]); w.z = cvt_pk_bf16(o1[0], o1[1]); w.w = cvt_pk_bf16(o1[2], o1[3]);
                    *(u32x4*)(rowp + bj * HALF) = w; } }
    }
};

template <class Epi, bool ALIGN_EPI = true>
__device__ __forceinline__ void gemm_phase(LAS unsigned char* lds, const Gemm g, const StaticOrder& S, const Epi& E) {
    int tid_ = threadIdx.x; asm volatile("" : "+v"(tid_)); const int tid = tid_, wid = __builtin_amdgcn_readfirstlane(tid >> 6), lane = tid & 63, wr = wid >> 2, wc = wid & 3, fr = lane & 15, fq = lane >> 4;
    const int K = g.K, nt = K / BK, lda = g.lda;
    unsigned voffA[2], voffB[2];
#pragma unroll
    for (int i = 0; i < 2; ++i) { int R, C; stage_rc(tid * 16 + i * 8192, R, C); const int Rb = Epi::PERM ? ((R & ~31) + perm32(R & 31)) : R;
        voffA[i] = (unsigned)(R * lda + C) * 2u; voffB[i] = (unsigned)(Rb * K + C) * 2u; }
    const size_t kstep = (size_t)(BK * 2);
    const size_t hstepA = (size_t)HALF * lda * 2, hstepB = (size_t)HALF * K * 2;
    const size_t tstepA = 2 * hstepA, tstepB = 2 * hstepB;
    const unsigned ldsw = (unsigned)wid * 1024u;
    const int aoff = lds_byte(wr * 64 + fr, fq * 8), boff = lds_byte(wc * 32 + fr, fq * 8);
#define PG8_SA(b, h) (((b) * 2 + (h)) * HTB)
#define PG8_SB(b, h) ((4 + (b) * 2 + (h)) * HTB)
#define PG8_STAGE(bufoff, gbase, voff) do { _Pragma("unroll") for (int _i = 0; _i < 2; ++_i) \
        __builtin_amdgcn_global_load_lds((const unsigned*)((const char*)(gbase) + (voff)[_i]), (LAS unsigned*)(lds + (bufoff) + ldsw + _i * 8192), 16, 0, 0); } while (0)
#define PG8_LDA(dst, b, h) do { _Pragma("unroll") for (int m = 0; m < 4; ++m) _Pragma("unroll") for (int k = 0; k < 2; ++k) dst[m][k] = *(const LAS bf16x8*)(lds + PG8_SA(b, h) + aoff + m * 2048 + k * 1024); } while (0)
#define PG8_LDB(dst, b, h) do { _Pragma("unroll") for (int n = 0; n < 2; ++n) _Pragma("unroll") for (int k = 0; k < 2; ++k) dst[n][k] = *(const LAS bf16x8*)(lds + PG8_SB(b, h) + boff + n * 2048 + k * 1024); } while (0)
#define PG8_MMA(ai, bj, At, Bt) do { __builtin_amdgcn_s_setprio(1); _Pragma("unroll") for (int m = 0; m < 4; ++m) _Pragma("unroll") for (int n = 0; n < 2; ++n) _Pragma("unroll") for (int k = 0; k < 2; ++k) \
        acc[ai][bj][m][n] = __builtin_amdgcn_mfma_f32_16x16x32_bf16(Bt[n][k], At[m][k], acc[ai][bj][m][n], 0, 0, 0); __builtin_amdgcn_s_setprio(0); } while (0)
#define PG8_WAIT_V(n) asm volatile("s_waitcnt vmcnt(" #n ")" ::: "memory")
#define PG8_WAIT_L(n) asm volatile("s_waitcnt lgkmcnt(" #n ")" ::: "memory")
#define PG8_BAR __builtin_amdgcn_s_barrier()
#define PG8_SCHED __builtin_amdgcn_sched_barrier(0)
    Unit cur, nxt; int ui = 0;
    if (!S.next(0, cur)) return;
    f32x4 acc[2][2][4][2];
#pragma unroll
    for (int a = 0; a < 2; ++a)
#pragma unroll
        for (int b = 0; b < 2; ++b)
#pragma unroll
            for (int m = 0; m < 4; ++m)
#pragma unroll
                for (int n = 0; n < 2; ++n) acc[a][b][m][n] = (f32x4){0.f, 0.f, 0.f, 0.f};
    bf16x8 At[4][2], B0[2][2], B1[2][2];
    const char* cA = (const char*)g.A + (size_t)cur.pm * tstepA; const char* cB = (const char*)g.Bt + (size_t)cur.pn * tstepB;
    PG8_STAGE(PG8_SB(0, 0), cB, voffB); PG8_STAGE(PG8_SB(0, 1), cB + hstepB, voffB); PG8_STAGE(PG8_SA(0, 0), cA, voffA); PG8_STAGE(PG8_SA(0, 1), cA + hstepA, voffA);
    if (wr == 1) PG8_BAR;
    PG8_WAIT_V(2); PG8_BAR;
    PG8_STAGE(PG8_SB(1, 0), cB + kstep, voffB); PG8_STAGE(PG8_SA(1, 0), cA + kstep, voffA); PG8_STAGE(PG8_SB(1, 1), cB + hstepB + kstep, voffB);
    PG8_WAIT_V(6); PG8_BAR;
    for (;;) {
        const bool has_next = S.next(ui + 1, nxt);
        const char* nA = has_next ? (const char*)g.A + (size_t)nxt.pm * tstepA : cA; const char* nB = has_next ? (const char*)g.Bt + (size_t)nxt.pn * tstepB : cB;
        for (int t = 0; t < nt; t += 2) {
            const bool last = (t == nt - 2);
            const char* a1 = cA + (size_t)(t + 1) * kstep;
            const char* a2 = last ? nA : cA + (size_t)(t + 2) * kstep; const char* b2 = last ? nB : cB + (size_t)(t + 2) * kstep;
            const char* a3 = a2 + kstep; const char* b3 = b2 + kstep;
            PG8_LDB(B0, 0, 0); PG8_LDB(B1, 0, 1); PG8_SCHED; PG8_LDA(At, 0, 0); PG8_STAGE(PG8_SA(1, 1), a1 + hstepA, voffA);
            PG8_WAIT_V(8); PG8_WAIT_L(0); PG8_BAR; PG8_MMA(0, 0, At, B0); PG8_MMA(0, 1, At, B1); PG8_BAR; PG8_SCHED;
            PG8_LDA(At, 0, 1); PG8_STAGE(PG8_SB(0, 0), b2, voffB); PG8_STAGE(PG8_SB(0, 1), b2 + hstepB, voffB); PG8_STAGE(PG8_SA(0, 0), a2, voffA);
            PG8_WAIT_V(8); PG8_WAIT_L(0); PG8_BAR; PG8_MMA(1, 0, At, B0); PG8_MMA(1, 1, At, B1); PG8_BAR; PG8_SCHED;
            PG8_LDB(B0, 1, 0); PG8_LDB(B1, 1, 1); PG8_SCHED; PG8_LDA(At, 1, 0); PG8_STAGE(PG8_SA(0, 1), a2 + hstepA, voffA);
            PG8_WAIT_V(8); PG8_WAIT_L(0); PG8_BAR; PG8_MMA(0, 0, At, B0); PG8_MMA(0, 1, At, B1); PG8_BAR; PG8_SCHED;
            PG8_LDA(At, 1, 1); PG8_STAGE(PG8_SB(1, 0), b3, voffB); PG8_STAGE(PG8_SB(1, 1), b3 + hstepB, voffB); PG8_STAGE(PG8_SA(1, 0), a3, voffA);
            PG8_WAIT_V(8); PG8_WAIT_L(0); PG8_BAR; PG8_MMA(1, 0, At, B0); PG8_MMA(1, 1, At, B1); PG8_BAR; PG8_SCHED;
        }
        if constexpr (ALIGN_EPI) { if (wr == 0) PG8_BAR; }
        E(acc, cur, wr, wc, fr, fq);
        if (!has_next) break;
#pragma unroll
        for (int a = 0; a < 2; ++a)
#pragma unroll
            for (int b = 0; b < 2; ++b)
#pragma unroll
                for (int m = 0; m < 4; ++m)
#pragma unroll
                    for (int n = 0; n < 2; ++n) acc[a][b][m][n] = (f32x4){0.f, 0.f, 0.f, 0.f};
        cur = nxt; cA = nA; cB = nB; ++ui;
        if constexpr (ALIGN_EPI) { if (wr == 1) PG8_BAR; }
    }
    PG8_WAIT_V(0);
    if constexpr (!ALIGN_EPI) { if (wr == 0) PG8_BAR; }
    PG8_BAR;
#undef PG8_SA
#undef PG8_SB
#undef PG8_STAGE
#undef PG8_LDA
#undef PG8_LDB
#undef PG8_MMA
#undef PG8_WAIT_V
#undef PG8_WAIT_L
#undef PG8_BAR
#undef PG8_SCHED
}
}

struct Args {
    const float* in[20];
    float* out; unsigned char* ws;
    int ph_lo, ph_hi;
};
enum { I_X = 0, I_C, I_CTX, I_CCTX, I_WMOD, I_BMOD, I_NORMG, I_WQKV, I_WO, I_LAMBDA, I_SUBLN, I_SWIN, I_SBIN, I_SLNG, I_SLNB, I_SWS, I_SBS, I_SWOUT, I_W1, I_W2 };

__device__ __forceinline__ void transpose_item(const float* W, int K, int N, bf16_t* WT, LAS float* scr, int item, int lane, int perm_cols) {
    const int nblk = N / 32, kb = item / nblk, nb = item % nblk, k0 = 64 * kb, n0 = 32 * nb;
#pragma unroll 8
    for (int i = 0; i < 32; ++i) { const int kk = 2 * i + (lane >> 5); scr[kk * 33 + (lane & 31)] = W[(size_t)(k0 + kk) * N + n0 + (lane & 31)]; }
    asm volatile("s_waitcnt lgkmcnt(0)" ::: "memory");
    const int c = lane & 7; const bool perm = n0 < perm_cols;
#pragma unroll
    for (int j = 0; j < 4; ++j) { const int n = (lane >> 3) + 8 * j; const int sn = perm ? ((n >> 1) + 16 * (n & 1)) : n; const LAS float* s = scr + (8 * c) * 33 + sn;
        u32x4 o; o.x = cvt_pk_bf16(s[0 * 33], s[1 * 33]); o.y = cvt_pk_bf16(s[2 * 33], s[3 * 33]); o.z = cvt_pk_bf16(s[4 * 33], s[5 * 33]); o.w = cvt_pk_bf16(s[6 * 33], s[7 * 33]);
        *(u32x4*)(WT + (size_t)(n0 + n) * K + k0 + 8 * c) = o; }
    asm volatile("s_waitcnt lgkmcnt(0)" ::: "memory");
}

__device__ __forceinline__ float silu_f(float v) { return v / (1.f + __expf(-v)); }

__device__ __forceinline__ void phase_prologue(const Args& a, LAS unsigned char* lds) {
    int tid_ = threadIdx.x; asm volatile("" : "+v"(tid_)); const int tid = tid_, lane = tid & 63, wave = tid >> 6, G = launder_s(gridDim.x), bx = launder_s(blockIdx.x);
    unsigned char* ws = a.ws;
    {
        LAS float* sl = (LAS float*)lds;
        LAS float* red = (LAS float*)(lds + 20480);
        if (bx < 192) {
            for (int i = tid; i < 5 * 1024; i += 512) { const int bb = i >> 10, k = i & 1023; const float v = (bb < 4) ? a.in[I_C][bb * 1024 + k] : a.in[I_CCTX][k]; sl[i] = silu_f(v); }
            __syncthreads();
            float* mod = (float*)(ws + WS_MOD);
            for (int it = bx; it < 192; it += G) {
                const int l = it / 48, cg_ = it % 48, col0 = cg_ * 128 + 2 * lane;
                const float* wp = a.in[I_WMOD] + ((size_t)l * 1024 + wave * 128) * 6144 + col0;
                float acc[5][2];
#pragma unroll
                for (int bb = 0; bb < 5; ++bb) { acc[bb][0] = 0.f; acc[bb][1] = 0.f; }
#pragma unroll 8
                for (int k = 0; k < 128; ++k) { const f32x2 w = *(const f32x2*)(wp + (size_t)k * 6144);
#pragma unroll
                    for (int bb = 0; bb < 5; ++bb) { const float s = sl[bb * 1024 + wave * 128 + k]; acc[bb][0] += s * w.x; acc[bb][1] += s * w.y; } }
#pragma unroll
                for (int bb = 0; bb < 5; ++bb) { red[(wave * 5 + bb) * 128 + 2 * lane] = acc[bb][0]; red[(wave * 5 + bb) * 128 + 2 * lane + 1] = acc[bb][1]; }
                __syncthreads();
                for (int o = tid; o < 640; o += 512) { const int bb = o >> 7, cc = o & 127; float s = 0.f;
#pragma unroll
                    for (int w = 0; w < 8; ++w) s += red[(w * 5 + bb) * 128 + cc];
                    const int n = cg_ * 128 + cc; mod[((size_t)l * 5 + bb) * 6144 + n] = s + a.in[I_BMOD][l * 6144 + n]; }
                __syncthreads();
            }
        }
        __syncthreads();
    }
    const int gt = bx * 512 + tid, NT = G * 512;
    { float* rope = (float*)(ws + WS_ROPE);
      for (int i = gt; i < 128 * 16; i += NT) { const int pos = i >> 4, p = i & 15; const float inv = powf(10000.f, -(float)p / 16.f); const float ang = (float)pos * inv; rope[2 * i] = cosf(ang); rope[2 * i + 1] = sinf(ang); }
      bf16_t* wsb = (bf16_t*)(ws + WS_WS); const float* src = a.in[I_SWS];
      for (int i = gt; i < 2 * 8 * 128 * 128 / 4; i += NT) { const f32x4 v = *(const f32x4*)(src + 4 * (size_t)i); u32x2 o; o.x = cvt_pk_bf16(v[0], v[1]); o.y = cvt_pk_bf16(v[2], v[3]); *(u32x2*)(wsb + 4 * (size_t)i) = o; } }
    {
        LAS float* scr = (LAS float*)(lds + wave * 8448);
        const int vcu = (G % 8 == 0) ? (bx % 8) * (G / 8) + bx / 8 : bx;
        const int gw = vcu * 8 + wave, NGW = G * 8;
        constexpr int I_Q = 16 * 96, I_O = 16 * 32, I_IN = 16 * 128, I_OUT = 32 * 32, I_1 = 16 * 128, I_2 = 64 * 32;
        constexpr int NITEMS = 2 * I_Q + 2 * I_O + 2 * I_IN + 2 * I_OUT + 4 * I_1 + 4 * I_2;
        for (int it = gw; it < NITEMS; it += NGW) {
            int r = it;
            if (r < 2 * I_Q) { const int j = r / I_Q; transpose_item(a.in[I_WQKV] + (size_t)j * 1024 * 3072, 1024, 3072, (bf16_t*)(ws + WS_WQKV) + (size_t)j * 3072 * 1024, scr, r % I_Q, lane, 2048); continue; } r -= 2 * I_Q;
            if (r < 2 * I_O) { const int j = r / I_O; transpose_item(a.in[I_WO] + (size_t)j * 1024 * 1024, 1024, 1024, (bf16_t*)(ws + WS_WO) + (size_t)j * 1024 * 1024, scr, r % I_O, lane, 0); continue; } r -= 2 * I_O;
            if (r < 2 * I_IN) { const int j = r / I_IN; transpose_item(a.in[I_SWIN] + (size_t)j * 1024 * 4096, 1024, 4096, (bf16_t*)(ws + WS_WIN) + (size_t)j * 4096 * 1024, scr, r % I_IN, lane, 0); continue; } r -= 2 * I_IN;
            if (r < 2 * I_OUT) { const int j = r / I_OUT; transpose_item(a.in[I_SWOUT] + (size_t)j * 2048 * 1024, 2048, 1024, (bf16_t*)(ws + WS_WOUT) + (size_t)j * 1024 * 2048, scr, r % I_OUT, lane, 0); continue; } r -= 2 * I_OUT;
            if (r < 4 * I_1) { const int j = r / I_1; transpose_item(a.in[I_W1] + (size_t)j * 1024 * 4096, 1024, 4096, (bf16_t*)(ws + WS_W1) + (size_t)j * 4096 * 1024, scr, r % I_1, lane, 0); continue; } r -= 4 * I_1;
            { const int j = r / I_2; transpose_item(a.in[I_W2] + (size_t)j * 4096 * 1024, 4096, 1024, (bf16_t*)(ws + WS_W2) + (size_t)j * 1024 * 4096, scr, r % I_2, lane, 0); }
        }
    }
}

struct RowPass {
    const float* xin_lat; const float* xin_ctx; float* xout_lat;
    const bf16_t* xin_bf; bf16_t* xout_bf;
    const bf16_t* Y; const float* g_post; const float* gate;
    bf16_t* A; const float* g_pre; const float* shift; const float* scale;
    int nrows;
};
constexpr int RP_R = 4;
__device__ __forceinline__ void phase_rowpass(const RowPass& p) {
    int tid_ = threadIdx.x; asm volatile("" : "+v"(tid_)); const int tid = tid_, lane = tid & 63, wave = tid >> 6, G = launder_s(gridDim.x);
    const int gw = launder_s(blockIdx.x) * 8 + wave, NGW = G * 8;
    for (int row0 = gw; row0 < p.nrows; row0 += RP_R * NGW) {
        int rows[RP_R]; bool ok[RP_R];
#pragma unroll
        for (int u = 0; u < RP_R; ++u) { rows[u] = row0 + u * NGW; ok[u] = rows[u] < p.nrows; if (!ok[u]) rows[u] = row0; }
        f32x4 v[RP_R][4]; u32x2 yw[RP_R][4];
#pragma unroll
        for (int u = 0; u < RP_R; ++u) { const int row = rows[u]; const bool lat = row < MLAT;
            if (p.xin_bf) { const bf16_t* xb = p.xin_bf + (size_t)row * D;
#pragma unroll
                for (int j = 0; j < 4; ++j) { const u32x2 w = *(const u32x2*)(xb + 4 * lane + 256 * j); v[u][j] = (f32x4){bf_lo(w.x), bf_hi(w.x), bf_lo(w.y), bf_hi(w.y)}; } }
            else { const float* xr = lat ? p.xin_lat + (size_t)row * D : p.xin_ctx + (size_t)(row - MLAT) * D;
#pragma unroll
                for (int j = 0; j < 4; ++j) v[u][j] = *(const f32x4*)(xr + 4 * lane + 256 * j); }
            if (p.Y) { const bf16_t* yr = p.Y + (size_t)row * D;
#pragma unroll
                for (int j = 0; j < 4; ++j) yw[u][j] = *(const u32x2*)(yr + 4 * lane + 256 * j); } }
#pragma unroll
        for (int u = 0; u < RP_R; ++u) { const int row = rows[u]; const bool lat = row < MLAT; const int bb = lat ? (row >> 13) : 4;
            if (!ok[u]) continue;
            if (p.Y) {
                f32x4 y[4]; float ss = 0.f;
#pragma unroll
                for (int j = 0; j < 4; ++j) { const u32x2 w = yw[u][j]; y[j] = (f32x4){bf_lo(w.x), bf_hi(w.x), bf_lo(w.y), bf_hi(w.y)}; ss += (y[j][0] * y[j][0] + y[j][1] * y[j][1]) + (y[j][2] * y[j][2] + y[j][3] * y[j][3]); }
                const float r = rsqrtf(wave_sum(ss) * (1.f / D) + EPS);
#pragma unroll
                for (int j = 0; j < 4; ++j) { const f32x4 gp = *(const f32x4*)(p.g_post + 4 * lane + 256 * j); const f32x4 gt = *(const f32x4*)(p.gate + (size_t)bb * 6144 + 4 * lane + 256 * j); v[u][j] = v[u][j] + gt * (y[j] * r * gp); }
            }
            if (p.xout_bf) { bf16_t* xb = p.xout_bf + (size_t)row * D;
#pragma unroll
                for (int j = 0; j < 4; ++j) { u32x2 w; w.x = cvt_pk_bf16(v[u][j][0], v[u][j][1]); w.y = cvt_pk_bf16(v[u][j][2], v[u][j][3]); *(u32x2*)(xb + 4 * lane + 256 * j) = w; } }
            if (p.xout_lat && lat) { float* xo = p.xout_lat + (size_t)row * D;
#pragma unroll
                for (int j = 0; j < 4; ++j) *(f32x4*)(xo + 4 * lane + 256 * j) = v[u][j]; }
            if (p.A) {
                float ss = 0.f;
#pragma unroll
                for (int j = 0; j < 4; ++j) ss += (v[u][j][0] * v[u][j][0] + v[u][j][1] * v[u][j][1]) + (v[u][j][2] * v[u][j][2] + v[u][j][3] * v[u][j][3]);
                const float r = rsqrtf(wave_sum(ss) * (1.f / D) + EPS);
                bf16_t* ar = p.A + (size_t)row * D;
#pragma unroll
                for (int j = 0; j < 4; ++j) { const f32x4 gp = *(const f32x4*)(p.g_pre + 4 * lane + 256 * j); const f32x4 sh = *(const f32x4*)(p.shift + (size_t)bb * 6144 + 4 * lane + 256 * j); const f32x4 sc = *(const f32x4*)(p.scale + (size_t)bb * 6144 + 4 * lane + 256 * j);
                    const f32x4 o = (v[u][j] * r * gp) * (sc + 1.f) + sh; u32x2 w; w.x = cvt_pk_bf16(o[0], o[1]); w.y = cvt_pk_bf16(o[2], o[3]); *(u32x2*)(ar + 4 * lane + 256 * j) = w; }
            }
        }
    }
}

constexpr int AT_STAGE = 32768;
__device__ __forceinline__ float swap32_max(float m) { auto rr = __builtin_amdgcn_permlane32_swap(__float_as_uint(m), __float_as_uint(m), false, false); return fmaxf(__uint_as_float(rr[0]), __uint_as_float(rr[1])); }
__device__ __forceinline__ float swap32_sum(float m) { auto rr = __builtin_amdgcn_permlane32_swap(__float_as_uint(m), __float_as_uint(m), false, false); return __uint_as_float(rr[0]) + __uint_as_float(rr[1]); }

__device__ __forceinline__ float at_sub(float a, float b) { return a - b; }
__device__ __forceinline__ float at_add(float a, float b) { return a + b; }
__device__ __forceinline__ void attn_unit(LAS unsigned char* lds, const bf16_t* QKV, bf16_t* O, int qrow0, int b, int h, int nt, float lam, float oscale, const float* subln_g) {
    int tid_ = threadIdx.x; asm volatile("" : "+v"(tid_)); const int tid = tid_, lane = tid & 63, wid = __builtin_amdgcn_readfirstlane(tid >> 6), r32 = lane & 31, hi = lane >> 5;
    const int map = wid >> 2, wq = wid & 3;
    const int lrow = tid >> 4, lch = tid & 15;
    const unsigned gofs = (unsigned)((lrow * QKVW + 1024 + h * 128 + lch * 8) * 2);
    const unsigned koff = (unsigned)((lch >> 3) * 8192 + lrow * 128 + (((lch & 7) ^ ((lrow >> 1) & 7)) << 4));
    const unsigned voff = (unsigned)((lch >> 2) * 4096 + (lrow >> 3) * 512 + (lrow & 7) * 64 + (lch & 3) * 16);
    u32x4 kr[2], vr[2];
#define AT_SB() __builtin_amdgcn_sched_barrier(0)
#define AT_TROW(t) (((t) < 4) ? (size_t)(MLAT + b * CTX + 64 * (t)) : (size_t)(b * SEQ + 64 * ((t) - 4)))
#define AT_GLOAD_K(t) do { const char* tb_ = (const char*)(QKV + AT_TROW(t) * QKVW) + gofs; kr[0] = *(const u32x4*)(tb_); kr[1] = *(const u32x4*)(tb_ + 32 * QKVW * 2); } while (0)
#define AT_GLOAD_V(t) do { const char* tb_ = (const char*)(QKV + AT_TROW(t) * QKVW) + gofs; vr[0] = *(const u32x4*)(tb_ + 2048); vr[1] = *(const u32x4*)(tb_ + 32 * QKVW * 2 + 2048); } while (0)
#define AT_LSTORE_K(so) do { *(LAS u32x4*)(lds + (so) + koff) = kr[0]; *(LAS u32x4*)(lds + (so) + koff + 4096) = kr[1]; } while (0)
#define AT_LSTORE_V(so) do { *(LAS u32x4*)(lds + (so) + voff) = vr[0]; *(LAS u32x4*)(lds + (so) + voff + 2048) = vr[1]; } while (0)
#define AT_MF(a, b, c) __builtin_amdgcn_mfma_f32_32x32x16_bf16((a), (b), (c), 0, 0, 0)
#define AT_KRD(s_) do { const int co_ = ((2 * (s_) + hi) ^ ksw) << 4; k0_[(s_) & 1] = *(const LAS bf16x8*)(kb_ + co_); k1_[(s_) & 1] = *(const LAS bf16x8*)(kb_ + 4096 + co_); } while (0)
#define AT_S(P0, P1, kso) do { LAS const unsigned char* kb_ = lds + (kso) + kbase; bf16x8 k0_[2], k1_[2]; const f32x16 z_ = {0.f,0.f,0.f,0.f,0.f,0.f,0.f,0.f,0.f,0.f,0.f,0.f,0.f,0.f,0.f,0.f}; \
        AT_KRD(0); AT_KRD(1); \
        P0 = AT_MF(k0_[0], qf[0], z_); P1 = AT_MF(k1_[0], qf[0], z_); AT_KRD(2); \
        P0 = AT_MF(k0_[1], qf[1], P0); P1 = AT_MF(k1_[1], qf[1], P1); AT_KRD(3); \
        P0 = AT_MF(k0_[0], qf[2], P0); P1 = AT_MF(k1_[0], qf[2], P1); \
        P0 = AT_MF(k0_[1], qf[3], P0); P1 = AT_MF(k1_[1], qf[3], P1); } while (0)
#define AT_ROWMAX(P0, P1, out) do { float ta_ = fmaxf(fmaxf(P0[0], P0[1]), P1[0]), tb_ = fmaxf(fmaxf(P0[2], P0[3]), P1[1]); ta_ = fmaxf(fmaxf(ta_, P1[2]), P1[3]); \
        _Pragma("unroll") for (int i_ = 4; i_ < 16; i_ += 4) { ta_ = fmaxf(fmaxf(ta_, P0[i_]), P0[i_ + 1]); tb_ = fmaxf(fmaxf(tb_, P0[i_ + 2]), P0[i_ + 3]); ta_ = fmaxf(fmaxf(ta_, P1[i_]), P1[i_ + 1]); tb_ = fmaxf(fmaxf(tb_, P1[i_ + 2]), P1[i_ + 3]); } \
        out = swap32_max(fmaxf(ta_, tb_)); } while (0)
#define AT_VRD(dst, c, kp) do { _Pragma("unroll") for (int k2_ = 0; k2_ < 2; ++k2_) { const int ks_ = 2 * (kp) + k2_; \
        const s16x4 lo_ = __builtin_bit_cast(s16x4, __builtin_amdgcn_ds_read_tr16_b64_v4i16((LAS s16x4*)(vb_ + (c) * 4096 + ks_ * 1024))); \
        const s16x4 hh_ = __builtin_bit_cast(s16x4, __builtin_amdgcn_ds_read_tr16_b64_v4i16((LAS s16x4*)(vb_ + (c) * 4096 + ks_ * 1024 + 512))); \
        dst[k2_] = __builtin_shufflevector(lo_, hh_, 0, 1, 2, 3, 4, 5, 6, 7); } } while (0)
#define AT_PVC(src, c, kp) do { _Pragma("unroll") for (int k2_ = 0; k2_ < 2; ++k2_) o[c] = AT_MF(src[k2_], pf[2 * (kp) + k2_], o[c]); } while (0)
#define AT_PVALL(vso, first_done) do { LAS const unsigned char* vb_ = lds + (vso) + vbase; \
        if (!(first_done)) { AT_VRD(va_, 0, 0); } \
        AT_SB(); AT_VRD(vc_, 0, 1); AT_SB(); AT_PVC(va_, 0, 0); AT_SB(); \
        AT_VRD(va_, 1, 0); AT_SB(); AT_PVC(vc_, 0, 1); AT_SB(); \
        AT_VRD(vc_, 1, 1); AT_SB(); AT_PVC(va_, 1, 0); AT_SB(); \
        AT_VRD(va_, 2, 0); AT_SB(); AT_PVC(vc_, 1, 1); AT_SB(); \
        AT_VRD(vc_, 2, 1); AT_SB(); AT_PVC(va_, 2, 0); AT_SB(); \
        AT_VRD(va_, 3, 0); AT_SB(); AT_PVC(vc_, 2, 1); AT_SB(); \
        AT_VRD(vc_, 3, 1); AT_SB(); AT_PVC(va_, 3, 0); AT_SB(); \
        AT_PVC(vc_, 3, 1); AT_SB(); } while (0)
#define AT_STEP(t, C0, C1, N0, N1, kso_next, kso_store) do { \
        const bool more1_ = (t) + 1 < nt, more2_ = (t) + 2 < nt; bf16x8 va_[2], vc_[2]; \
        if (more2_) AT_GLOAD_K((t) + 2); if (more1_) AT_GLOAD_V((t) + 1); \
        if (map == 1 && (t) > 0) AT_PVALL(vs_prev, false); \
        if (more1_) AT_S(N0, N1, kso_next); \
        float tm_; AT_ROWMAX(C0, C1, tm_); \
        if (__any(tm_ > mrun + 8.0f)) { const float mn_ = fmaxf(tm_, mrun); const float al_ = __builtin_amdgcn_exp2f(mrun - mn_); mrun = mn_; lrun *= al_; \
            _Pragma("unroll") for (int c_ = 0; c_ < 4; ++c_) _Pragma("unroll") for (int i_ = 0; i_ < 16; ++i_) o[c_][i_] *= al_; } \
        if (map == 0) { LAS const unsigned char* vb_ = lds + vs_cur + vbase; AT_VRD(va_, 0, 0); } AT_SB(); \
        float sacc_ = 0.f; \
        _Pragma("unroll") for (int i_ = 0; i_ < 16; i_ += 2) { C0[i_] = __builtin_amdgcn_exp2f(at_sub(C0[i_], mrun)); C0[i_ + 1] = __builtin_amdgcn_exp2f(at_sub(C0[i_ + 1], mrun)); C1[i_] = __builtin_amdgcn_exp2f(at_sub(C1[i_], mrun)); C1[i_ + 1] = __builtin_amdgcn_exp2f(at_sub(C1[i_ + 1], mrun)); \
            sacc_ += C0[i_]; sacc_ += C0[i_ + 1]; sacc_ += C1[i_]; sacc_ += C1[i_ + 1]; asm volatile("" : "+v"(sacc_)); } \
        lrun += sacc_; \
        { u32x4 w_; \
          w_.x = cvt_pk_bf16(C0[0], C0[1]); w_.y = cvt_pk_bf16(C0[2], C0[3]); w_.z = cvt_pk_bf16(C0[4], C0[5]); w_.w = cvt_pk_bf16(C0[6], C0[7]); pf[0] = __builtin_bit_cast(bf16x8, w_); \
          w_.x = cvt_pk_bf16(C0[8], C0[9]); w_.y = cvt_pk_bf16(C0[10], C0[11]); w_.z = cvt_pk_bf16(C0[12], C0[13]); w_.w = cvt_pk_bf16(C0[14], C0[15]); pf[1] = __builtin_bit_cast(bf16x8, w_); \
          w_.x = cvt_pk_bf16(C1[0], C1[1]); w_.y = cvt_pk_bf16(C1[2], C1[3]); w_.z = cvt_pk_bf16(C1[4], C1[5]); w_.w = cvt_pk_bf16(C1[6], C1[7]); pf[2] = __builtin_bit_cast(bf16x8, w_); \
          w_.x = cvt_pk_bf16(C1[8], C1[9]); w_.y = cvt_pk_bf16(C1[10], C1[11]); w_.z = cvt_pk_bf16(C1[12], C1[13]); w_.w = cvt_pk_bf16(C1[14], C1[15]); pf[3] = __builtin_bit_cast(bf16x8, w_); } \
        if (map == 0) AT_PVALL(vs_cur, true); \
        if (more2_) AT_LSTORE_K(kso_store); if (more1_) AT_LSTORE_V(vs_next); \
        __syncthreads(); \
        vs_prev = vs_cur; vs_cur = vs_next; vs_next = (vs_next == 32768 + 2 * 16384) ? 32768 : vs_next + 16384; } while (0)

    const int kbase = map * 8192 + r32 * 128; const int ksw = (r32 >> 1) & 7;
    const int vbase = ((lane >> 4) & 1) * 32 + (lane & 3) * 8 + (4 * hi + ((lane & 15) >> 2)) * 64;
    AT_GLOAD_K(0); AT_GLOAD_V(0);
    bf16x8 qf[4];
    { const bf16_t* qp = QKV + (size_t)(qrow0 + wq * 32 + r32) * QKVW + h * 128 + map * 64 + hi * 8;
#pragma unroll
      for (int s = 0; s < 4; ++s) qf[s] = *(const bf16x8*)(qp + 16 * s); }
    AT_LSTORE_K(0); AT_LSTORE_V(32768);
    AT_GLOAD_K(1); AT_LSTORE_K(16384);
    __syncthreads();
    f32x16 o[4], pA0, pA1, pB0, pB1;
#pragma unroll
    for (int c = 0; c < 4; ++c)
#pragma unroll
        for (int i = 0; i < 16; ++i) o[c][i] = 0.f;
#pragma unroll
    for (int i = 0; i < 16; ++i) { pB0[i] = 0.f; pB1[i] = 0.f; }
    bf16x8 pf[4];
    float mrun, lrun = 0.f;
    int vs_prev = 32768 + 2 * 16384, vs_cur = 32768, vs_next = 32768 + 16384;
    AT_S(pA0, pA1, 0);
    { float tm0; AT_ROWMAX(pA0, pA1, tm0); mrun = tm0; }
    asm volatile("s_nop 7\n\ts_nop 7" ::: "memory");
    __syncthreads();
    for (int it = 0; it < nt; it += 2) {
        AT_STEP(it,     pA0, pA1, pB0, pB1, 16384, 0);
        AT_STEP(it + 1, pB0, pB1, pA0, pA1, 0,     16384);
    }
    if (map == 1) { bf16x8 va_[2], vc_[2]; AT_PVALL(vs_prev, false); }
    __syncthreads();
#undef AT_SB
#undef AT_TROW
#undef AT_GLOAD_K
#undef AT_GLOAD_V
#undef AT_LSTORE_K
#undef AT_LSTORE_V
#undef AT_MF
#undef AT_S
#undef AT_KRD
#undef AT_ROWMAX
#undef AT_VRD
#undef AT_PVC
#undef AT_PVALL
#undef AT_STEP
    const float inv = 1.f / swap32_sum(lrun);
    LAS float* ex = (LAS float*)lds;
    if (map == 1) {
#pragma unroll
        for (int c = 0; c < 4; ++c)
#pragma unroll
            for (int i = 0; i < 16; ++i) ex[((wq * 64) + c * 16 + i) * 64 + lane] = o[c][i] * inv;
    }
    __syncthreads();
    if (map == 0) {
        float ss = 0.f;
#pragma unroll
        for (int c = 0; c < 4; ++c)
#pragma unroll
            for (int i = 0; i < 16; ++i) { const float v = o[c][i] * inv - lam * ex[((wq * 64) + c * 16 + i) * 64 + lane]; o[c][i] = v; ss += v * v; }
        ss = swap32_sum(ss);
        const float r = rsqrtf(ss * (1.f / 128.f) + EPS) * oscale;
        bf16_t* op = O + (size_t)(qrow0 + wq * 32 + r32) * D + h * 128;
#pragma unroll
        for (int c = 0; c < 4; ++c)
#pragma unroll
            for (int g4 = 0; g4 < 4; ++g4) { const int d = 32 * c + 8 * g4 + 4 * hi; const f32x4 gv = *(const f32x4*)(subln_g + d);
                u32x2 w; w.x = cvt_pk_bf16(o[c][4 * g4] * r * gv[0], o[c][4 * g4 + 1] * r * gv[1]); w.y = cvt_pk_bf16(o[c][4 * g4 + 2] * r * gv[2], o[c][4 * g4 + 3] * r * gv[3]);
                *(u32x2*)(op + d) = w; }
    }
    __syncthreads();
}

__device__ __forceinline__ void phase_attention(const Args& a, LAS unsigned char* lds, int layer, bool ctx_queries) {
    int tid_ = threadIdx.x; asm volatile("" : "+v"(tid_)); const int G = launder_s(gridDim.x), bx = launder_s(blockIdx.x), lane = tid_ & 63;
    const int j = layer >> 1;
    const float lam_init = (layer == 0) ? 0.2f : 0.47071301f;
    const float* lp = a.in[I_LAMBDA] + j * 256;
    const float s1 = wave_sum(lp[lane] * lp[64 + lane]), s2 = wave_sum(lp[128 + lane] * lp[192 + lane]);
    const float lam = expf(s1) - expf(s2) + lam_init;
    const float oscale = 1.f - lam_init;
    const bf16_t* QKV = (const bf16_t*)(a.ws + WS_BIG); bf16_t* O = (bf16_t*)(a.ws + WS_BIG + (size_t)MALL * QKVW * 2);
    const float* sg = a.in[I_SUBLN] + j * 128;
    if (G == 256) {
        const int vcu = (bx % 8) * 32 + bx / 8;
        for (int i = 0; i < 8; ++i) { const int bh = (vcu >> 5) * 4 + (i >> 1), qb = (i & 1) * 32 + (vcu & 31); const int b = bh >> 3, h = bh & 7;
            attn_unit(lds, QKV, O, b * SEQ + qb * 128, b, h, 132, lam, oscale, sg); }
    } else {
        for (int idx = bx; idx < 2048; idx += G) { const int bh = idx >> 6, qb = idx & 63; const int b = bh >> 3, h = bh & 7;
            attn_unit(lds, QKV, O, b * SEQ + qb * 128, b, h, 132, lam, oscale, sg); }
    }
    if (ctx_queries) {
        for (int idx = bx; idx < 64; idx += G) { const int bh = idx >> 1, qb = idx & 1; const int b = bh >> 3, h = bh & 7;
            attn_unit(lds, QKV, O, MLAT + b * CTX + qb * 128, b, h, 4, lam, oscale, sg); }
    }
}

__device__ __forceinline__ void phase_lnstats(const Args& a, int nrows) {
    int tid_ = threadIdx.x; asm volatile("" : "+v"(tid_)); const int tid = tid_, lane = tid & 63, wave = tid >> 6, G = launder_s(gridDim.x);
    const int gw = launder_s(blockIdx.x) * 8 + wave, NGW = G * 8;
    const bf16_t* Z = (const bf16_t*)(a.ws + WS_BIG); float* st = (float*)(a.ws + WS_LNST);
    for (int row0 = gw; row0 < nrows; row0 += 2 * NGW) {
        u32x4 w[2][4]; int rows[2]; rows[0] = row0; rows[1] = row0 + NGW; const bool ok1 = rows[1] < nrows; if (!ok1) rows[1] = row0;
#pragma unroll
        for (int u = 0; u < 2; ++u) { const bf16_t* zr = Z + (size_t)rows[u] * SGUW + SGUH;
#pragma unroll
            for (int j = 0; j < 4; ++j) w[u][j] = *(const u32x4*)(zr + 8 * lane + 512 * j); }
#pragma unroll
        for (int u = 0; u < 2; ++u) { if (u == 1 && !ok1) continue;
            float v[32]; float s = 0.f;
#pragma unroll
            for (int j = 0; j < 4; ++j) { const u32x4 x = w[u][j];
                v[8 * j + 0] = bf_lo(x.x); v[8 * j + 1] = bf_hi(x.x); v[8 * j + 2] = bf_lo(x.y); v[8 * j + 3] = bf_hi(x.y); v[8 * j + 4] = bf_lo(x.z); v[8 * j + 5] = bf_hi(x.z); v[8 * j + 6] = bf_lo(x.w); v[8 * j + 7] = bf_hi(x.w); }
#pragma unroll
            for (int i = 0; i < 32; ++i) s += v[i];
            const float mu = wave_sum(s) * (1.f / SGUH); float q = 0.f;
#pragma unroll
            for (int i = 0; i < 32; ++i) { const float d = v[i] - mu; q += d * d; }
            const float rstd = rsqrtf(wave_sum(q) * (1.f / SGUH) + EPS);
            if (lane == 0) { st[2 * rows[u]] = mu; st[2 * rows[u] + 1] = rstd; } }
    }
}

__device__ __forceinline__ void phase_spatial(const Args& a, LAS unsigned char* lds, int j, int nchunks) {
    int tid_ = threadIdx.x; asm volatile("" : "+v"(tid_)); const int tid = tid_, lane = tid & 63, wid = __builtin_amdgcn_readfirstlane(tid >> 6), r32 = lane & 31, hi = lane >> 5, G = launder_s(gridDim.x);
    bf16_t* Z = (bf16_t*)(a.ws + WS_BIG); const float* st = (const float*)(a.ws + WS_LNST);
    const bf16_t* wsb = (const bf16_t*)(a.ws + WS_WS) + (size_t)j * 8 * 16384;
    const float* lng = a.in[I_SLNG] + j * SGUH; const float* lnb = a.in[I_SLNB] + j * SGUH; const float* bs = a.in[I_SBS] + j * 8 * 128;
    LAS unsigned char* vt = lds;
    LAS unsigned char* wl = lds + 67584;
    int gcur = -1;
    const int lch = tid & 31, lrow = tid >> 5;
    u32x4 vw[8]; f32x2 vms[8];
#define SP_PREFETCH(IDX) do { const int c_ = (IDX) >> 3, g_ = (IDX) & 7; const size_t r0_ = (size_t)c_ * 128; _Pragma("unroll") for (int p = 0; p < 8; ++p) { const int row = lrow + 16 * p; \
        vw[p] = *(const u32x4*)(Z + (r0_ + row) * SGUW + SGUH + g_ * 256 + lch * 8); vms[p] = *(const f32x2*)(st + 2 * (r0_ + row)); } } while (0)
    { const int i0 = launder_s(blockIdx.x); if (i0 < nchunks * 8) SP_PREFETCH(i0); }
    for (int idx = launder_s(blockIdx.x); idx < nchunks * 8; idx += G) {
        const int chunk = idx >> 3, g = idx & 7; const size_t row0 = (size_t)chunk * 128;
        if (g != gcur) {
#pragma unroll
            for (int p = 0; p < 4; ++p) { const int i = tid + 512 * p; const int row = i >> 4, ch = i & 15; const u32x4 w = *(const u32x4*)(wsb + (size_t)g * 16384 + row * 128 + ch * 8);
                *(LAS u32x4*)(wl + row * 256 + ((ch ^ (row & 15)) << 4)) = w; }
            gcur = g;
        }
        {
            f32x4 g0 = *(const f32x4*)(lng + g * 256 + lch * 8), g1 = *(const f32x4*)(lng + g * 256 + lch * 8 + 4), b0 = *(const f32x4*)(lnb + g * 256 + lch * 8), b1 = *(const f32x4*)(lnb + g * 256 + lch * 8 + 4);
#pragma unroll
            for (int p = 0; p < 8; ++p) { const int row = lrow + 16 * p; const u32x4 w = vw[p]; const f32x2 ms = vms[p];
                f32x4 x0 = {bf_lo(w.x), bf_hi(w.x), bf_lo(w.y), bf_hi(w.y)}, x1 = {bf_lo(w.z), bf_hi(w.z), bf_lo(w.w), bf_hi(w.w)};
                x0 = (x0 - ms.x) * ms.y * g0 + b0; x1 = (x1 - ms.x) * ms.y * g1 + b1;
                u32x4 o; o.x = cvt_pk_bf16(x0[0], x0[1]); o.y = cvt_pk_bf16(x0[2], x0[3]); o.z = cvt_pk_bf16(x1[0], x1[1]); o.w = cvt_pk_bf16(x1[2], x1[3]);
                *(LAS u32x4*)(vt + (lch >> 2) * 8192 + (row >> 3) * 512 + (row & 7) * 64 + (lch & 3) * 16) = o; }
        }
        __syncthreads();
        if (idx + G < nchunks * 8) SP_PREFETCH(idx + G);
        u32x4 uu[8];
#pragma unroll
        for (int p8 = 0; p8 < 8; ++p8) { const int row = lrow + 16 * p8; uu[p8] = *(const u32x4*)(Z + (row0 + row) * SGUW + g * 256 + lch * 8); }
        f32x16 acc[4];
#pragma unroll
        for (int pb = 0; pb < 4; ++pb)
#pragma unroll
            for (int i = 0; i < 16; ++i) acc[pb][i] = 0.f;
        const int vb = wid * 8192 + ((lane >> 4) & 1) * 32 + (lane & 3) * 8 + ((lane & 15) >> 2) * 64;
#pragma unroll
        for (int ks = 0; ks < 8; ++ks) {
            const s16x4 lo = __builtin_bit_cast(s16x4, __builtin_amdgcn_ds_read_tr16_b64_v4i16((LAS s16x4*)(vt + vb + (2 * ks + hi) * 512)));
            const s16x4 hh = __builtin_bit_cast(s16x4, __builtin_amdgcn_ds_read_tr16_b64_v4i16((LAS s16x4*)(vt + vb + (2 * ks + hi) * 512 + 256)));
            const bf16x8 vf = __builtin_shufflevector(lo, hh, 0, 1, 2, 3, 4, 5, 6, 7);
#pragma unroll
            for (int pb = 0; pb < 4; ++pb) { const int row = 32 * pb + r32; const bf16x8 wf = *(const LAS bf16x8*)(wl + row * 256 + (((2 * ks + hi) ^ (row & 15)) << 4));
                acc[pb] = __builtin_amdgcn_mfma_f32_32x32x16_bf16(vf, wf, acc[pb], 0, 0, 0); }
        }
        __syncthreads();
#pragma unroll
        for (int pb = 0; pb < 4; ++pb) { const int p = 32 * pb + r32; const float bias = bs[g * 128 + p];
#pragma unroll
            for (int g4 = 0; g4 < 4; ++g4) { u32x2 w; w.x = cvt_pk_bf16(acc[pb][4 * g4] + bias, acc[pb][4 * g4 + 1] + bias); w.y = cvt_pk_bf16(acc[pb][4 * g4 + 2] + bias, acc[pb][4 * g4 + 3] + bias);
                *(LAS u32x2*)(vt + p * 520 + (32 * wid + 8 * g4 + 4 * hi) * 2) = w; } }
        __syncthreads();
        {
#pragma unroll
          for (int p8 = 0; p8 < 8; ++p8) { const int row = lrow + 16 * p8; const u32x2 s0 = *(const LAS u32x2*)(vt + row * 520 + lch * 16), s1 = *(const LAS u32x2*)(vt + row * 520 + lch * 16 + 8);
              u32x4 o; o.x = cvt_pk_bf16(bf_lo(uu[p8].x) * bf_lo(s0.x), bf_hi(uu[p8].x) * bf_hi(s0.x)); o.y = cvt_pk_bf16(bf_lo(uu[p8].y) * bf_lo(s0.y), bf_hi(uu[p8].y) * bf_hi(s0.y));
              o.z = cvt_pk_bf16(bf_lo(uu[p8].z) * bf_lo(s1.x), bf_hi(uu[p8].z) * bf_hi(s1.x)); o.w = cvt_pk_bf16(bf_lo(uu[p8].w) * bf_lo(s1.y), bf_hi(uu[p8].w) * bf_hi(s1.y));
              *(u32x4*)(Z + (row0 + row) * SGUW + g * 256 + lch * 8) = o; } }
        __syncthreads();
    }
}
#undef SP_PREFETCH

__device__ __forceinline__ void ctx_gemm(LAS unsigned char* lds, const bf16_t* A, int lda, const bf16_t* Bt, int K, bf16_t* Y) {
    int tid_ = threadIdx.x; asm volatile("" : "+v"(tid_)); const int tid = tid_, lane = tid & 63, wid = __builtin_amdgcn_readfirstlane(tid >> 6), fr = lane & 15, fq = lane >> 4;
    LAS f32x4* red = (LAS f32x4*)lds;
    const int G = launder_s(gridDim.x);
    for (int idx = launder_s(blockIdx.x); idx < 256; idx += G) {
        const int tm = idx >> 4, tn = idx & 15, kw = K >> 3;
        const bf16_t* ap = A + (size_t)(MLAT + tm * 64 + fr) * lda + wid * kw + 8 * fq;
        const bf16_t* bp = Bt + (size_t)(tn * 64 + fr) * K + wid * kw + 8 * fq;
        f32x4 acc[4][4];
#pragma unroll
        for (int i = 0; i < 4; ++i)
#pragma unroll
            for (int j = 0; j < 4; ++j) acc[i][j] = (f32x4){0.f, 0.f, 0.f, 0.f};
        for (int k0 = 0; k0 < kw; k0 += 64) {
            bf16x8 af[2][4], bf[2][4];
#pragma unroll
            for (int u = 0; u < 2; ++u)
#pragma unroll
                for (int i = 0; i < 4; ++i) { af[u][i] = *(const bf16x8*)(ap + (size_t)(16 * i) * lda + k0 + 32 * u); bf[u][i] = *(const bf16x8*)(bp + (size_t)(16 * i) * K + k0 + 32 * u); }
#pragma unroll
            for (int u = 0; u < 2; ++u)
#pragma unroll
                for (int i = 0; i < 4; ++i)
#pragma unroll
                    for (int j = 0; j < 4; ++j) acc[i][j] = __builtin_amdgcn_mfma_f32_16x16x32_bf16(bf[u][j], af[u][i], acc[i][j], 0, 0, 0);
        }
#pragma unroll
        for (int half = 4; half >= 1; half >>= 1) {
            if (wid >= half && wid < 2 * half) {
#pragma unroll
                for (int i = 0; i < 4; ++i)
#pragma unroll
                    for (int j = 0; j < 4; ++j) red[((wid - half) * 16 + i * 4 + j) * 64 + lane] = acc[i][j]; }
            __syncthreads();
            if (wid < half) {
#pragma unroll
                for (int i = 0; i < 4; ++i)
#pragma unroll
                    for (int j = 0; j < 4; ++j) acc[i][j] = acc[i][j] + red[(wid * 16 + i * 4 + j) * 64 + lane]; }
            __syncthreads();
        }
        if (wid == 0) {
#pragma unroll
            for (int i = 0; i < 4; ++i) { bf16_t* yp = Y + (size_t)(MLAT + tm * 64 + 16 * i + fr) * D + tn * 64 + 4 * fq;
#pragma unroll
                for (int j = 0; j < 4; ++j) { u32x2 w; w.x = cvt_pk_bf16(acc[i][j][0], acc[i][j][1]); w.y = cvt_pk_bf16(acc[i][j][2], acc[i][j][3]); *(u32x2*)(yp + 16 * j) = w; } }
        }
    }
}

#define XB_TMO      128
#define XB_XCNT(j)  (256  + 64 * (j))
#define XB_XSUB(j)  (1280 + 64 * (j))
#define XB_XGEN(j)  (2304 + 64 * (j))
#define XB_TOP      3328
#define XB_TOPGEN   3392
#define XCD_BAR_WORDS 3456
#define XB_SPIN_CAP (1u << 22)
__device__ __forceinline__ unsigned xb_ld(unsigned* p)              { return __hip_atomic_load(p, __ATOMIC_RELAXED, __HIP_MEMORY_SCOPE_AGENT); }
__device__ __forceinline__ unsigned xb_add(unsigned* p, unsigned v) { return __hip_atomic_fetch_add(p, v, __ATOMIC_RELAXED, __HIP_MEMORY_SCOPE_AGENT); }
__device__ __forceinline__ unsigned xb_xcc_id() { return (unsigned)__builtin_amdgcn_s_getreg((3 << 11) | 20) & 0xFu; }
#define XB_SPIN(cond, bar) do { unsigned _sp = 0; while (cond) { __builtin_amdgcn_s_sleep(1); \
    if ((++_sp & 255u) == 0u) { if (xb_ld(&(bar)[XB_TMO])) break; if (_sp > XB_SPIN_CAP) { atomicAdd(&(bar)[XB_TMO], 1u); break; } } } } while (0)
struct XcdBarrier { unsigned* bar; unsigned x; volatile LAS unsigned* st; };
__device__ __forceinline__ XcdBarrier xcd_barrier_post(unsigned* bar, volatile LAS unsigned* st) {
    XcdBarrier b; b.bar = bar; b.x = xb_xcc_id(); b.st = st;
    int t0_ = threadIdx.x; asm volatile("" : "+v"(t0_));
    if (t0_ == 0) (void)xb_add(&bar[XB_XCNT(b.x)], 1u);
    return b;
}
__device__ __forceinline__ void xcd_barrier_complete(unsigned* bar, unsigned x, unsigned& nloc, unsigned& nx) {
    const unsigned G = gridDim.x * gridDim.y * gridDim.z;
    unsigned sum, cnt, mine, sp = 0u;
    for (;;) {
        sum = 0u; cnt = 0u; mine = 0u;
#pragma unroll
        for (unsigned j = 0; j < 16; ++j) { const unsigned c = xb_ld(&bar[XB_XCNT(j)]); sum += c; cnt += (c > 0u) ? 1u : 0u; mine = (j == x) ? c : mine; }
        if (sum == G) break;
        __builtin_amdgcn_s_sleep(1);
        if ((++sp & 255u) == 0u) { if (xb_ld(&bar[XB_TMO])) break; if (sp > XB_SPIN_CAP) { atomicAdd(&bar[XB_TMO], 1u); break; } }
    }
    nloc = mine > 0u ? mine : 1u; nx = cnt > 0u ? cnt : 1u;
}
__device__ __forceinline__ void xcd_barrier(const XcdBarrier& b) {
    asm volatile("s_waitcnt vmcnt(0)" ::: "memory");
    __syncthreads();
    int t0_ = threadIdx.x; asm volatile("" : "+v"(t0_));
    if (t0_ == 0) {
        unsigned* bar = b.bar;
        __builtin_amdgcn_s_waitcnt(0);
        unsigned nloc = b.st[0], nx = b.st[1];
        if (nloc == 0u) { xcd_barrier_complete(bar, b.x, nloc, nx); b.st[0] = nloc; b.st[1] = nx; }
        const unsigned old = xb_add(&bar[XB_XSUB(b.x)], 1u);
        const unsigned gen = old / nloc;
        if (old + 1u == (gen + 1u) * nloc) {
            __builtin_amdgcn_fence(__ATOMIC_RELEASE, "agent");
            asm volatile("s_waitcnt vmcnt(0)" ::: "memory");
            const unsigned og = xb_add(&bar[XB_TOP], 1u);
            const unsigned tg = og / nx;
            if (og + 1u == (tg + 1u) * nx) xb_add(&bar[XB_TOPGEN], 1u);
            else XB_SPIN(xb_ld(&bar[XB_TOPGEN]) == tg, bar);
            __builtin_amdgcn_fence(__ATOMIC_ACQUIRE, "agent");
            xb_add(&bar[XB_XGEN(b.x)], 1u);
            asm volatile("s_waitcnt vmcnt(0)" ::: "memory");
        } else {
            XB_SPIN(xb_ld(&bar[XB_XGEN(b.x)]) == gen, bar);
            __builtin_amdgcn_fence(__ATOMIC_ACQUIRE, "agent");
            asm volatile("s_waitcnt vmcnt(0)" ::: "memory");
        }
    }
    __syncthreads();
}

constexpr int LDS_BYTES = 147456;
constexpr int NPHASES = 32;
#ifndef MK_MASK
#define MK_MASK 0xffff
#endif
#define EN(b) ((MK_MASK >> (b)) & 1)
#ifndef MK_DUP
#define MK_DUP 0
#endif
#define DUP(b) ((MK_DUP >> (b)) & 1)

__global__ void __launch_bounds__(512) fwd_megakernel(Args a) {
    extern __shared__ __attribute__((aligned(16))) unsigned char lds_raw[];
    LAS unsigned char* lds = (LAS unsigned char*)lds_raw;
    cg::grid_group grid = cg::this_grid();
    unsigned char* ws = a.ws;
    const float* mod = (const float*)(ws + WS_MOD);
    const float* normg = a.in[I_NORMG];
    bf16_t* Xbf = (bf16_t*)(ws + WS_Y);
    bf16_t* Abuf = (bf16_t*)(ws + WS_A); bf16_t* Ybuf = Abuf; bf16_t* Big = (bf16_t*)(ws + WS_BIG);
    bf16_t* Obuf = (bf16_t*)(ws + WS_BIG + (size_t)MALL * QKVW * 2);

    volatile LAS unsigned* bst = (volatile LAS unsigned*)(lds + 131072 + 1024);
    if (threadIdx.x == 0) { bst[0] = 0u; bst[1] = 0u; }
    __syncthreads();
    XcdBarrier xbar; xbar.bar = (unsigned*)ws; xbar.x = 0; xbar.st = bst;
    for (int ph = a.ph_lo; ph < a.ph_hi; ++ph) {
        asm volatile("" : "+s"(ws));
        const int G = launder_s(gridDim.x), bxl = launder_s(blockIdx.x);
        if (ph == 0) {
            if (bxl == 0) { int t0_ = threadIdx.x; asm volatile("" : "+v"(t0_)); for (int i = t0_; i < XCD_BAR_WORDS; i += 512) __hip_atomic_store((unsigned*)a.ws + i, 0u, __ATOMIC_RELAXED, __HIP_MEMORY_SCOPE_AGENT); }
            if (EN(0)) phase_prologue(a, lds);
            if (DUP(0)) { __syncthreads(); phase_prologue(a, lds); }
        } else if (ph == 1) {
            RowPass p{}; p.xin_lat = a.in[I_X]; p.xin_ctx = a.in[I_CTX]; p.xout_lat = nullptr; p.xin_bf = nullptr; p.xout_bf = nullptr; p.Y = nullptr; p.g_post = nullptr; p.gate = nullptr;
            p.A = Abuf; p.g_pre = normg + 0 * 4096 + 0 * 1024; p.shift = mod + 0; p.scale = mod + 1024; p.nrows = MALL;
            if (EN(1)) phase_rowpass(p);
        } else {
            int layer, k;
            if (ph < 9) { layer = 0; k = ph - 2; } else if (ph < 17) { layer = 1; k = ph - 9; } else if (ph < 24) { layer = 2; k = ph - 17; } else { layer = 3; k = ph - 24; }
            const bool attn = (layer & 1) == 0; const int j = layer >> 1;
            int kind = attn ? (k == 0 ? 0 : k == 1 ? 1 : k + 1) : k;
            const bool ctx_all = layer < 2;
            const int Mfull = ctx_all ? MALL : MLAT;
            const float* lmod = mod + (size_t)layer * 5 * 6144; const float* lg = normg + layer * 4096;
            const bf16_t* cgA = nullptr; const bf16_t* cgB = nullptr; int cgLda = 0, cgK = 0;
            if (kind == 0) {
                if (attn) { pg8::Gemm g{Abuf, (const bf16_t*)(ws + WS_WQKV) + (size_t)j * QKVW * D, (layer == 2) ? MALL : Mfull, QKVW, D, D}; pg8::StaticOrder S; S.init(g.M, g.N, G, bxl);
                    pg8::EpiQKV E{Big, (const float*)(ws + WS_ROPE)}; if (EN(2)) pg8::gemm_phase<pg8::EpiQKV>(lds, g, S, E); if (DUP(2)) pg8::gemm_phase<pg8::EpiQKV>(lds, g, S, E); }
                else { pg8::Gemm g{Abuf, (const bf16_t*)(ws + WS_WIN) + (size_t)j * SGUW * D, Mfull, SGUW, D, D}; pg8::StaticOrder S; S.init(g.M, g.N, G, bxl);
                    pg8::EpiBf16<1> E{Big, SGUW, a.in[I_SBIN] + j * SGUW}; if (EN(3)) pg8::gemm_phase<pg8::EpiBf16<1>>(lds, g, S, E); if (DUP(3)) pg8::gemm_phase<pg8::EpiBf16<1>>(lds, g, S, E); }
            } else if (kind == 1) {
                if (attn) { if (EN(6)) phase_attention(a, lds, layer, layer == 0); if (DUP(6)) { __syncthreads(); phase_attention(a, lds, layer, layer == 0); } }
                else { if (EN(7)) phase_lnstats(a, Mfull); }
            } else if (kind == 2) {
                if (EN(8)) phase_spatial(a, lds, j, Mfull / 128);
            } else if (kind == 3) {
                if (attn) { pg8::Gemm g{Obuf, (const bf16_t*)(ws + WS_WO) + (size_t)j * D * D, MLAT, D, D, D}; pg8::StaticOrder S; S.init(g.M, g.N, G, bxl);
                    pg8::EpiBf16<0> E{Ybuf, D, nullptr}; if (EN(4)) pg8::gemm_phase<pg8::EpiBf16<0>>(lds, g, S, E); if (DUP(4)) pg8::gemm_phase<pg8::EpiBf16<0>>(lds, g, S, E); }
                else { pg8::Gemm g{Big, (const bf16_t*)(ws + WS_WOUT) + (size_t)j * D * SGUH, MLAT, D, SGUH, SGUW}; pg8::StaticOrder S; S.init(g.M, g.N, G, bxl);
                    pg8::EpiBf16<0> E{Ybuf, D, nullptr}; if (EN(4)) pg8::gemm_phase<pg8::EpiBf16<0>>(lds, g, S, E); if (DUP(4)) pg8::gemm_phase<pg8::EpiBf16<0>>(lds, g, S, E); }
                if (ctx_all) {
                    if (attn) { cgA = Obuf; cgLda = D; cgB = (const bf16_t*)(ws + WS_WO) + (size_t)j * D * D; cgK = D; }
                    else { cgA = Big; cgLda = SGUW; cgB = (const bf16_t*)(ws + WS_WOUT) + (size_t)j * D * SGUH; cgK = SGUH; } }
            } else if (kind == 4) {
                RowPass p{}; const bool first = (layer == 0);
                p.xin_lat = a.in[I_X]; p.xin_ctx = a.in[I_CTX]; p.xin_bf = first ? nullptr : Xbf; p.xout_lat = nullptr; p.xout_bf = Xbf;
                p.Y = Ybuf; p.g_post = lg + 1024; p.gate = lmod + 2 * 1024;
                p.A = Abuf; p.g_pre = lg + 2048; p.shift = lmod + 3 * 1024; p.scale = lmod + 4 * 1024; p.nrows = Mfull;
                if (EN(1)) phase_rowpass(p);
            } else if (kind == 5) {
                pg8::Gemm g{Abuf, (const bf16_t*)(ws + WS_W1) + (size_t)layer * FF * D, Mfull, FF, D, D}; pg8::StaticOrder S; S.init(g.M, g.N, G, bxl);
                pg8::EpiBf16<2> E{Big, FF, nullptr}; if (EN(5)) pg8::gemm_phase<pg8::EpiBf16<2>>(lds, g, S, E); if (DUP(5)) pg8::gemm_phase<pg8::EpiBf16<2>>(lds, g, S, E);
            } else if (kind == 6) {
                pg8::Gemm g{Big, (const bf16_t*)(ws + WS_W2) + (size_t)layer * D * FF, MLAT, D, FF, FF}; pg8::StaticOrder S; S.init(g.M, g.N, G, bxl);
                pg8::EpiBf16<0> E{Ybuf, D, nullptr}; if (EN(4)) pg8::gemm_phase<pg8::EpiBf16<0>>(lds, g, S, E); if (DUP(4)) pg8::gemm_phase<pg8::EpiBf16<0>>(lds, g, S, E);
                if (ctx_all) { cgA = Big; cgLda = FF; cgB = (const bf16_t*)(ws + WS_W2) + (size_t)layer * D * FF; cgK = FF; }
            } else {
                RowPass p{}; p.xin_lat = nullptr; p.xin_ctx = nullptr; p.xin_bf = Xbf; p.xout_lat = (layer == 3) ? a.out : nullptr; p.xout_bf = (layer == 3) ? nullptr : Xbf;
                p.Y = Ybuf; p.g_post = lg + 3072; p.gate = lmod + 5 * 1024;
                if (layer < 3) { const float* nmod = mod + (size_t)(layer + 1) * 5 * 6144; p.A = Abuf; p.g_pre = normg + (layer + 1) * 4096; p.shift = nmod; p.scale = nmod + 1024; }
                else { p.A = nullptr; p.g_pre = nullptr; p.shift = nullptr; p.scale = nullptr; }
                p.nrows = (layer == 1) ? MALL : Mfull;
                if (EN(1)) phase_rowpass(p);
            }
            if (cgK) ctx_gemm(lds, cgA, cgLda, cgB, cgK, Ybuf);
        }
        if (ph + 1 < a.ph_hi) {
            if (ph == 0) { grid.sync(); xbar = xcd_barrier_post((unsigned*)a.ws, bst); }
            else { xcd_barrier(xbar); if (DUP(15)) { xcd_barrier(xbar); xcd_barrier(xbar); } }
        }
    }
}

#ifndef MK_PER_PHASE
#define MK_PER_PHASE 0
#endif
extern "C" void kernel_launch(void* const* d_in, const int* in_sizes, int n_in, void* d_out, int out_size, void* d_ws, size_t ws_size, hipStream_t stream) {
    static int grid = 0;
    if (grid == 0) {
        if (n_in != 20 || in_sizes[0] != MLAT * D || out_size != MLAT * D || ws_size < WS_END) {
            fprintf(stderr, "kernel_launch: unexpected shapes: n_in %d in0 %d out %d ws %zu (need %zu)\n", n_in, n_in > 0 ? in_sizes[0] : -1, out_size, ws_size, (size_t)WS_END); grid = -1; return; }
        int dev = 0, cus = 0, per_cu = 0;
        hipGetDevice(&dev); hipDeviceGetAttribute(&cus, hipDeviceAttributeMultiprocessorCount, dev);
        if (hipFuncSetAttribute((const void*)fwd_megakernel, hipFuncAttributeMaxDynamicSharedMemorySize, LDS_BYTES) != hipSuccess) { fprintf(stderr, "kernel_launch: hipFuncSetAttribute failed\n"); grid = -1; return; }
        if (hipOccupancyMaxActiveBlocksPerMultiprocessor(&per_cu, (const void*)fwd_megakernel, 512, LDS_BYTES) != hipSuccess || per_cu < 1) { fprintf(stderr, "kernel_launch: occupancy query says %d\n", per_cu); per_cu = 1; }
        (void)hipGetLastError();
        grid = cus * (per_cu > 1 ? 1 : per_cu);
        fprintf(stderr, "kernel_launch: grid %d (cus %d, per_cu %d)\n", grid, cus, per_cu);
    }
    if (grid < 0) return;
    Args a{};
    for (int i = 0; i < 20; ++i) a.in[i] = (const float*)d_in[i];
    a.out = (float*)d_out; a.ws = (unsigned char*)d_ws;
#if MK_PER_PHASE
    for (int ph = 0; ph < NPHASES; ++ph) { a.ph_lo = ph; a.ph_hi = ph + 1; hipLaunchKernelGGL(fwd_megakernel, dim3(grid), dim3(512), LDS_BYTES, stream, a); }
#else
    a.ph_lo = 0; a.ph_hi = NPHASES;
    void* args[] = {&a};
    hipError_t e = hipLaunchCooperativeKernel((const void*)fwd_megakernel, dim3(grid), dim3(512), args, LDS_BYTES, stream);
    if (e != hipSuccess) fprintf(stderr, "kernel_launch: cooperative launch failed: %s (grid %d)\n", hipGetErrorString(e), grid);
#endif
}
```

```cpp
#include <hip/hip_runtime.h>
#include <hip/hip_cooperative_groups.h>
#include <cstdio>
#include <cstdint>
namespace cg = cooperative_groups;

#define LAS __attribute__((address_space(3)))
typedef unsigned short bf16_t;
typedef short bf16x8 __attribute__((ext_vector_type(8)));
typedef short s16x4 __attribute__((ext_vector_type(4)));
typedef float f32x4 __attribute__((ext_vector_type(4)));
typedef float f32x2 __attribute__((ext_vector_type(2)));
typedef float f32x16 __attribute__((ext_vector_type(16)));
typedef unsigned u32x4 __attribute__((ext_vector_type(4)));
typedef unsigned u32x2 __attribute__((ext_vector_type(2)));
typedef __bf16 bf16x2_t __attribute__((ext_vector_type(2)));

constexpr int D = 1024, NB = 4, SEQ = 8192, CTX = 256, MLAT = NB * SEQ, MCTX = NB * CTX, MALL = MLAT + MCTX;
constexpr int NMOD = 6, QKVW = 3072, FF = 4096, SGUW = 4096, SGUH = 2048;
constexpr float EPS = 1e-6f;
constexpr float QSCALE = 0.125f * 1.4426950408889634f;

constexpr size_t MiB = 1u << 20;
constexpr size_t WS_MOD = 1 * MiB;
constexpr size_t WS_ROPE = 1 * MiB + 512 * 1024;
constexpr size_t WS_WS = 2 * MiB;
constexpr size_t WS_LNST = 2 * MiB + 512 * 1024;
constexpr size_t WS_WQKV = 3 * MiB;
constexpr size_t WS_WO = 15 * MiB;
constexpr size_t WS_WIN = 19 * MiB;
constexpr size_t WS_WOUT = 35 * MiB;
constexpr size_t WS_W1 = 43 * MiB;
constexpr size_t WS_W2 = 75 * MiB;
constexpr size_t WS_XCTX = 107 * MiB;
constexpr size_t WS_A = 111 * MiB;
constexpr size_t WS_Y = 177 * MiB;
constexpr size_t WS_BIG = 243 * MiB;
constexpr size_t WS_END = 507 * MiB;

__device__ __forceinline__ unsigned cvt_pk_bf16(float lo, float hi) { f32x2 v = {lo, hi}; bf16x2_t b = __builtin_convertvector(v, bf16x2_t); return __builtin_bit_cast(unsigned, b); }
__device__ __forceinline__ float bf_lo(unsigned u) { return __uint_as_float(u << 16); }
__device__ __forceinline__ float bf_hi(unsigned u) { return __uint_as_float(u & 0xffff0000u); }
__device__ __forceinline__ float wave_sum(float v) {
#pragma unroll
    for (int o = 1; o < 64; o <<= 1) v += __shfl_xor(v, o);
    return v;
}

__device__ __forceinline__ int launder_s(int v) { asm volatile("" : "+s"(v)); return v; }
namespace pg8 {
constexpr int BM = 256, BK = 64, HALF = 128, HTB = HALF * BK * 2, STAGE_BYTES = 8 * HTB, NXCD = 8, WGM = 4;
__host__ __device__ __forceinline__ int lds_byte(int r, int c) { const int st = (r >> 4) * 2 + (c >> 5), rr = r & 15, cc = c & 31, ob = rr * 64 + cc * 2; return st * 1024 + (ob ^ (((ob >> 9) & 1) << 5)); }
__host__ __device__ __forceinline__ void stage_rc(int b, int& R, int& C) { const int st = b / 1024, sb = b % 1024, swz = sb ^ (((sb >> 9) & 1) << 5); R = (st >> 1) * 16 + swz / 64; C = (st & 1) * 32 + (swz % 64) / 2; }
__host__ __device__ __forceinline__ int perm32(int rho) { const int n = rho >> 4, i = rho & 15; return 8 * (i >> 2) + 4 * n + (i & 3); }

struct Unit { int pm, pn; };
struct Gemm { const bf16_t* A; const bf16_t* Bt; int M, N, K, lda; };

struct StaticOrder {
    int nM, nN, nwg, G, c, rev;
    __device__ void init(int M, int N, int G_, int c_, int rev_ = 0) { nM = M / BM; nN = N / BM; nwg = nM * nN; G = G_; c = c_; rev = rev_; }
    __device__ bool next(int i, Unit& u) const {
        const long L = (long)i * G + c; if (L >= nwg) return false;
        int wgid = (int)L; { const int q = nwg / NXCD, r = nwg % NXCD, xcd = wgid % NXCD, off = wgid / NXCD; wgid = (xcd < r ? xcd * (q + 1) : r * (q + 1) + (xcd - r) * q) + off; }
        const int nig = WGM * nN, gid = wgid / nig, fm = gid * WGM, gsz = (nM - fm) < WGM ? (nM - fm) : WGM;
        u.pm = fm + ((wgid % nig) % gsz); u.pn = (wgid % nig) / gsz; if (rev) u.pm = nM - 1 - u.pm; return true;
    }
};

__device__ __forceinline__ f32x2 gelu_pk(f32x2 v) {
    const f32x2 av = __builtin_elementwise_abs(v), d = av * 0.2316418882f + 1.0f;
    f32x2 t; t.x = __builtin_amdgcn_rcpf(d.x); t.y = __builtin_amdgcn_rcpf(d.y);
    f32x2 q = t * 0.5307027145f + (-0.7265760135f); q = q * t + 0.7107068705f; q = q * t + (-0.142248368f); q = q * t + 0.127414796f; q = q * t;
    const f32x2 s = (v * v) * (-0.72134752044f);
    f32x2 e; e.x = __builtin_amdgcn_exp2f(s.x); e.y = __builtin_amdgcn_exp2f(s.y);
    const f32x2 m = v * (q * e), r = v - m;
    f32x2 o; o.x = v.x < 0.f ? m.x : r.x; o.y = v.y < 0.f ? m.y : r.y; return o;
}

template <int ACT  > struct EpiBf16 {
    static constexpr bool PERM = true;
    bf16_t* O; int ldc; const float* bias;
    __device__ __forceinline__ void operator()(const f32x4 (&acc)[2][2][4][2], const Unit& u, int wr, int wc, int fr, int fq) const {
        const int row0 = u.pm * BM + wr * 64 + fr; const int col0 = u.pn * BM + wc * 32 + 8 * fq;
        f32x4 bv[2][2];
#pragma unroll
        for (int bj = 0; bj < 2; ++bj)
#pragma unroll
            for (int n = 0; n < 2; ++n) bv[bj][n] = bias ? *(const f32x4*)(bias + col0 + bj * HALF + 4 * n) : (f32x4){0.f, 0.f, 0.f, 0.f};
#pragma unroll
        for (int ai = 0; ai < 2; ++ai)
#pragma unroll
            for (int m = 0; m < 4; ++m) { bf16_t* rowp = O + (size_t)(row0 + ai * HALF + m * 16) * ldc + col0;
#pragma unroll
                for (int bj = 0; bj < 2; ++bj) { f32x4 v0 = acc[ai][bj][m][0] + bv[bj][0], v1 = acc[ai][bj][m][1] + bv[bj][1];
                    if (ACT == 1) { f32x2 a = gelu_pk((f32x2){v0[0], v0[1]}), b = gelu_pk((f32x2){v0[2], v0[3]}), c = gelu_pk((f32x2){v1[0], v1[1]}), d = gelu_pk((f32x2){v1[2], v1[3]});
                        v0 = (f32x4){a.x, a.y, b.x, b.y}; v1 = (f32x4){c.x, c.y, d.x, d.y}; }
                    if (ACT == 2) {
#pragma unroll
                        for (int e = 0; e < 4; ++e) { const float a = fmaxf(v0[e], 0.f), b = fmaxf(v1[e], 0.f); v0[e] = a * a; v1[e] = b * b; } }
                    u32x4 w; w.x = cvt_pk_bf16(v0[0], v0[1]); w.y = cvt_pk_bf16(v0[2], v0[3]); w.z = cvt_pk_bf16(v1[0], v1[1]); w.w = cvt_pk_bf16(v1[2], v1[3]);
                    *(u32x4*)(rowp + bj * HALF) = w; } }
    }
};
struct EpiQKV {
    static constexpr bool PERM = true;
    bf16_t* O; const float* rope;
    __device__ __forceinline__ void operator()(const f32x4 (&acc)[2][2][4][2], const Unit& u, int wr, int wc, int fr, int fq) const {
        const int row0 = u.pm * BM + wr * 64 + fr; const int col0 = u.pn * BM + wc * 32 + 8 * fq;
        const bool do_rope = (u.pn < 8) && (u.pm < MLAT / BM);
        const float sc = (u.pn < 4) ? QSCALE : 1.f;
#pragma unroll
        for (int ai = 0; ai < 2; ++ai)
#pragma unroll
            for (int m = 0; m < 4; ++m) { const int row = row0 + ai * HALF + m * 16; bf16_t* rowp = O + (size_t)row * QKVW + col0;
                f32x4 cs0 = {1.f, 0.f, 1.f, 0.f}, cs1 = {1.f, 0.f, 1.f, 0.f};
                if (do_rope) { const int s = row & (SEQ - 1); const int pos = (wc & 1) ? (s & 63) : (s >> 6); const float* t = rope + (pos * 16 + 4 * fq) * 2; cs0 = *(const f32x4*)t; cs1 = *(const f32x4*)(t + 4); }
#pragma unroll
                for (int bj = 0; bj < 2; ++bj) { const f32x4 v0 = acc[ai][bj][m][0], v1 = acc[ai][bj][m][1]; f32x4 o0, o1;
                    o0[0] = v0[0] * cs0[0] - v0[1] * cs0[1]; o0[1] = v0[1] * cs0[0] + v0[0] * cs0[1];
                    o0[2] = v0[2] * cs0[2] - v0[3] * cs0[3]; o0[3] = v0[3] * cs0[2] + v0[2] * cs0[3];
                    o1[0] = v1[0] * cs1[0] - v1[1] * cs1[1]; o1[1] = v1[1] * cs1[0] + v1[0] * cs1[1];
                    o1[2] = v1[2] * cs1[2] - v1[3] * cs1[3]; o1[3] = v1[3] * cs1[2] + v1[2] * cs1[3];
                    o0 = o0 * sc; o1 = o1 * sc;
                    u32x4 w; w.x = cvt_pk_bf16(o0[0], o0[1]); w.y = cvt_pk_bf16(o0[2], o0[3]); w.z = cvt_pk_bf16(o1[0], o1[1]); w.w = cvt_pk_bf16(o1[2], o1[3]);
                    *(u32x4*)(rowp + bj * HALF) = w; } }
    }
};

template <class Epi, bool ALIGN_EPI = true>
__device__ __forceinline__ void gemm_phase(LAS unsigned char* lds, const Gemm g, const StaticOrder& S, const Epi& E) {
    int tid_ = threadIdx.x; asm volatile("" : "+v"(tid_)); const int tid = tid_, wid = __builtin_amdgcn_readfirstlane(tid >> 6), lane = tid & 63, wr = wid >> 2, wc = wid & 3, fr = lane & 15, fq = lane >> 4;
    const int K = g.K, nt = K / BK, lda = g.lda;
    unsigned voffA[2], voffB[2];
#pragma unroll
    for (int i = 0; i < 2; ++i) { int R, C; stage_rc(tid * 16 + i * 8192, R, C); const int Rb = Epi::PERM ? ((R & ~31) + perm32(R & 31)) : R;
        voffA[i] = (unsigned)(R * lda + C) * 2u; voffB[i] = (unsigned)(Rb * K + C) * 2u; }
    const size_t kstep = (size_t)(BK * 2);
    const size_t hstepA = (size_t)HALF * lda * 2, hstepB = (size_t)HALF * K * 2;
    const size_t tstepA = 2 * hstepA, tstepB = 2 * hstepB;
    const unsigned ldsw = (unsigned)wid * 1024u;
    const int aoff = lds_byte(wr * 64 + fr, fq * 8), boff = lds_byte(wc * 32 + fr, fq * 8);
#define PG8_SA(b, h) (((b) * 2 + (h)) * HTB)
#define PG8_SB(b, h) ((4 + (b) * 2 + (h)) * HTB)
#define PG8_STAGE(bufoff, gbase, voff) do { _Pragma("unroll") for (int _i = 0; _i < 2; ++_i) \
        __builtin_amdgcn_global_load_lds((const unsigned*)((const char*)(gbase) + (voff)[_i]), (LAS unsigned*)(lds + (bufoff) + ldsw + _i * 8192), 16, 0, 0); } while (0)
#define PG8_LDA(dst, b, h) do { _Pragma("unroll") for (int m = 0; m < 4; ++m) _Pragma("unroll") for (int k = 0; k < 2; ++k) dst[m][k] = *(const LAS bf16x8*)(lds + PG8_SA(b, h) + aoff + m * 2048 + k * 1024); } while (0)
#define PG8_LDB(dst, b, h) do { _Pragma("unroll") for (int n = 0; n < 2; ++n) _Pragma("unroll") for (int k = 0; k < 2; ++k) dst[n][k] = *(const LAS bf16x8*)(lds + PG8_SB(b, h) + boff + n * 2048 + k * 1024); } while (0)
#define PG8_MMA(ai, bj, At, Bt) do { __builtin_amdgcn_s_setprio(1); _Pragma("unroll") for (int m = 0; m < 4; ++m) _Pragma("unroll") for (int n = 0; n < 2; ++n) _Pragma("unroll") for (int k = 0; k < 2; ++k) \
        acc[ai][bj][m][n] = __builtin_amdgcn_mfma_f32_16x16x32_bf16(Bt[n][k], At[m][k], acc[ai][bj][m][n], 0, 0, 0); __builtin_amdgcn_s_setprio(0); } while (0)
#define PG8_WAIT_V(n) asm volatile("s_waitcnt vmcnt(" #n ")" ::: "memory")
#define PG8_WAIT_L(n) asm volatile("s_waitcnt lgkmcnt(" #n ")" ::: "memory")
#define PG8_BAR __builtin_amdgcn_s_barrier()
#define PG8_SCHED __builtin_amdgcn_sched_barrier(0)
    Unit cur, nxt; int ui = 0;
    if (!S.next(0, cur)) return;
    f32x4 acc[2][2][4][2];
#pragma unroll
    for (int a = 0; a < 2; ++a)
#pragma unroll
        for (int b = 0; b < 2; ++b)
#pragma unroll
            for (int m = 0; m < 4; ++m)
#pragma unroll
                for (int n = 0; n < 2; ++n) acc[a][b][m][n] = (f32x4){0.f, 0.f, 0.f, 0.f};
    bf16x8 At[4][2], B0[2][2], B1[2][2];
    const char* cA = (const char*)g.A + (size_t)cur.pm * tstepA; const char* cB = (const char*)g.Bt + (size_t)cur.pn * tstepB;
    PG8_STAGE(PG8_SB(0, 0), cB, voffB); PG8_STAGE(PG8_SB(0, 1), cB + hstepB, voffB); PG8_STAGE(PG8_SA(0, 0), cA, voffA); PG8_STAGE(PG8_SA(0, 1), cA + hstepA, voffA);
    if (wr == 1) PG8_BAR;
    PG8_WAIT_V(2); PG8_BAR;
    PG8_STAGE(PG8_SB(1, 0), cB + kstep, voffB); PG8_STAGE(PG8_SA(1, 0), cA + kstep, voffA); PG8_STAGE(PG8_SB(1, 1), cB + hstepB + kstep, voffB);
    PG8_WAIT_V(6); PG8_BAR;
    for (;;) {
        const bool has_next = S.next(ui + 1, nxt);
        const char* nA = has_next ? (const char*)g.A + (size_t)nxt.pm * tstepA : cA; const char* nB = has_next ? (const char*)g.Bt + (size_t)nxt.pn * tstepB : cB;
        for (int t = 0; t < nt; t += 2) {
            const bool last = (t == nt - 2);
            const char* a1 = cA + (size_t)(t + 1) * kstep;
            const char* a2 = last ? nA : cA + (size_t)(t + 2) * kstep; const char* b2 = last ? nB : cB + (size_t)(t + 2) * kstep;
            const char* a3 = a2 + kstep; const char* b3 = b2 + kstep;
            PG8_LDB(B0, 0, 0); PG8_LDB(B1, 0, 1); PG8_SCHED; PG8_LDA(At, 0, 0); PG8_STAGE(PG8_SA(1, 1), a1 + hstepA, voffA);
            PG8_WAIT_V(8); PG8_WAIT_L(0); PG8_BAR; PG8_MMA(0, 0, At, B0); PG8_MMA(0, 1, At, B1); PG8_BAR; PG8_SCHED;
            PG8_LDA(At, 0, 1); PG8_STAGE(PG8_SB(0, 0), b2, voffB); PG8_STAGE(PG8_SB(0, 1), b2 + hstepB, voffB); PG8_STAGE(PG8_SA(0, 0), a2, voffA);
            PG8_WAIT_V(8); PG8_WAIT_L(0); PG8_BAR; PG8_MMA(1, 0, At, B0); PG8_MMA(1, 1, At, B1); PG8_BAR; PG8_SCHED;
            PG8_LDB(B0, 1, 0); PG8_LDB(B1, 1, 1); PG8_SCHED; PG8_LDA(At, 1, 0); PG8_STAGE(PG8_SA(0, 1), a2 + hstepA, voffA);
            PG8_WAIT_V(8); PG8_WAIT_L(0); PG8_BAR; PG8_MMA(0, 0, At, B0); PG8_MMA(0, 1, At, B1); PG8_BAR; PG8_SCHED;
            PG8_LDA(At, 1, 1); PG8_STAGE(PG8_SB(1, 0), b3, voffB); PG8_STAGE(PG8_SB(1, 1), b3 + hstepB, voffB); PG8_STAGE(PG8_SA(1, 0), a3, voffA);
            PG8_WAIT_V(8); PG8_WAIT_L(0); PG8_BAR; PG8_MMA(1, 0, At, B0); PG8_MMA(1, 1, At, B1); PG8_BAR; PG8_SCHED;
        }
        if constexpr (ALIGN_EPI) { if (wr == 0) PG8_BAR; }
        E(acc, cur, wr, wc, fr, fq);
        if (!has_next) break;
#pragma unroll
        for (int a = 0; a < 2; ++a)
#pragma unroll
            for (int b = 0; b < 2; ++b)
#pragma unroll
                for (int m = 0; m < 4; ++m)
#pragma unroll
                    for (int n = 0; n < 2; ++n) acc[a][b][m][n] = (f32x4){0.f, 0.f, 0.f, 0.f};
        cur = nxt; cA = nA; cB = nB; ++ui;
        if constexpr (ALIGN_EPI) { if (wr == 1) PG8_BAR; }
    }
    PG8_WAIT_V(0);
    if constexpr (!ALIGN_EPI) { if (wr == 0) PG8_BAR; }
    PG8_BAR;
#undef PG8_SA
#undef PG8_SB
#undef PG8_STAGE
#undef PG8_LDA
#undef PG8_LDB
#undef PG8_MMA
#undef PG8_WAIT_V
#undef PG8_WAIT_L
#undef PG8_BAR
#undef PG8_SCHED
}
}

struct Args {
    const float* in[20];
    float* out; unsigned char* ws;
    int ph_lo, ph_hi;
};
enum { I_X = 0, I_C, I_CTX, I_CCTX, I_WMOD, I_BMOD, I_NORMG, I_WQKV, I_WO, I_LAMBDA, I_SUBLN, I_SWIN, I_SBIN, I_SLNG, I_SLNB, I_SWS, I_SBS, I_SWOUT, I_W1, I_W2 };

__device__ __forceinline__ void transpose_item(const float* W, int K, int N, bf16_t* WT, LAS float* scr, int item, int lane, int perm_cols) {
    const int nblk = N / 32, kb = item / nblk, nb = item % nblk, k0 = 64 * kb, n0 = 32 * nb;
#pragma unroll 8
    for (int i = 0; i < 32; ++i) { const int kk = 2 * i + (lane >> 5); scr[kk * 33 + (lane & 31)] = W[(size_t)(k0 + kk) * N + n0 + (lane & 31)]; }
    asm volatile("s_waitcnt lgkmcnt(0)" ::: "memory");
    const int c = lane & 7; const bool perm = n0 < perm_cols;
#pragma unroll
    for (int j = 0; j < 4; ++j) { const int n = (lane >> 3) + 8 * j; const int sn = perm ? ((n >> 1) + 16 * (n & 1)) : n; const LAS float* s = scr + (8 * c) * 33 + sn;
        u32x4 o; o.x = cvt_pk_bf16(s[0 * 33], s[1 * 33]); o.y = cvt_pk_bf16(s[2 * 33], s[3 * 33]); o.z = cvt_pk_bf16(s[4 * 33], s[5 * 33]); o.w = cvt_pk_bf16(s[6 * 33], s[7 * 33]);
        *(u32x4*)(WT + (size_t)(n0 + n) * K + k0 + 8 * c) = o; }
    asm volatile("s_waitcnt lgkmcnt(0)" ::: "memory");
}

__device__ __forceinline__ float silu_f(float v) { return v / (1.f + __expf(-v)); }

__device__ __forceinline__ void phase_prologue(const Args& a, LAS unsigned char* lds) {
    int tid_ = threadIdx.x; asm volatile("" : "+v"(tid_)); const int tid = tid_, lane = tid & 63, wave = tid >> 6, G = launder_s(gridDim.x), bx = launder_s(blockIdx.x);
    unsigned char* ws = a.ws;
    {
        LAS float* sl = (LAS float*)lds;
        LAS float* red = (LAS float*)(lds + 20480);
        if (bx < 192) {
            for (int i = tid; i < 5 * 1024; i += 512) { const int bb = i >> 10, k = i & 1023; const float v = (bb < 4) ? a.in[I_C][bb * 1024 + k] : a.in[I_CCTX][k]; sl[i] = silu_f(v); }
            __syncthreads();
            float* mod = (float*)(ws + WS_MOD);
            for (int it = bx; it < 192; it += G) {
                const int l = it / 48, cg_ = it % 48, col0 = cg_ * 128 + 2 * lane;
                const float* wp = a.in[I_WMOD] + ((size_t)l * 1024 + wave * 128) * 6144 + col0;
                float acc[5][2];
#pragma unroll
                for (int bb = 0; bb < 5; ++bb) { acc[bb][0] = 0.f; acc[bb][1] = 0.f; }
#pragma unroll 8
                for (int k = 0; k < 128; ++k) { const f32x2 w = *(const f32x2*)(wp + (size_t)k * 6144);
#pragma unroll
                    for (int bb = 0; bb < 5; ++bb) { const float s = sl[bb * 1024 + wave * 128 + k]; acc[bb][0] += s * w.x; acc[bb][1] += s * w.y; } }
#pragma unroll
                for (int bb = 0; bb < 5; ++bb) { red[(wave * 5 + bb) * 128 + 2 * lane] = acc[bb][0]; red[(wave * 5 + bb) * 128 + 2 * lane + 1] = acc[bb][1]; }
                __syncthreads();
                for (int o = tid; o < 640; o += 512) { const int bb = o >> 7, cc = o & 127; float s = 0.f;
#pragma unroll
                    for (int w = 0; w < 8; ++w) s += red[(w * 5 + bb) * 128 + cc];
                    const int n = cg_ * 128 + cc; mod[((size_t)l * 5 + bb) * 6144 + n] = s + a.in[I_BMOD][l * 6144 + n]; }
                __syncthreads();
            }
        }
        __syncthreads();
    }
    const int gt = bx * 512 + tid, NT = G * 512;
    { float* rope = (float*)(ws + WS_ROPE);
      for (int i = gt; i < 128 * 16; i += NT) { const int pos = i >> 4, p = i & 15; const float inv = powf(10000.f, -(float)p / 16.f); const float ang = (float)pos * inv; rope[2 * i] = cosf(ang); rope[2 * i + 1] = sinf(ang); }
      bf16_t* wsb = (bf16_t*)(ws + WS_WS); const float* src = a.in[I_SWS];
      for (int i = gt; i < 2 * 8 * 128 * 128 / 4; i += NT) { const f32x4 v = *(const f32x4*)(src + 4 * (size_t)i); u32x2 o; o.x = cvt_pk_bf16(v[0], v[1]); o.y = cvt_pk_bf16(v[2], v[3]); *(u32x2*)(wsb + 4 * (size_t)i) = o; } }
    {
        LAS float* scr = (LAS float*)(lds + wave * 8448);
        const int vcu = (G % 8 == 0) ? (bx % 8) * (G / 8) + bx / 8 : bx;
        const int gw = vcu * 8 + wave, NGW = G * 8;
        constexpr int I_Q = 16 * 96, I_O = 16 * 32, I_IN = 16 * 128, I_OUT = 32 * 32, I_1 = 16 * 128, I_2 = 64 * 32;
        constexpr int NITEMS = 2 * I_Q + 2 * I_O + 2 * I_IN + 2 * I_OUT + 4 * I_1 + 4 * I_2;
        for (int it = gw; it < NITEMS; it += NGW) {
            int r = it;
            if (r < 2 * I_Q) { const int j = r / I_Q; transpose_item(a.in[I_WQKV] + (size_t)j * 1024 * 3072, 1024, 3072, (bf16_t*)(ws + WS_WQKV) + (size_t)j * 3072 * 1024, scr, r % I_Q, lane, 2048); continue; } r -= 2 * I_Q;
            if (r < 2 * I_O) { const int j = r / I_O; transpose_item(a.in[I_WO] + (size_t)j * 1024 * 1024, 1024, 1024, (bf16_t*)(ws + WS_WO) + (size_t)j * 1024 * 1024, scr, r % I_O, lane, 0); continue; } r -= 2 * I_O;
            if (r < 2 * I_IN) { const int j = r / I_IN; transpose_item(a.in[I_SWIN] + (size_t)j * 1024 * 4096, 1024, 4096, (bf16_t*)(ws + WS_WIN) + (size_t)j * 4096 * 1024, scr, r % I_IN, lane, 0); continue; } r -= 2 * I_IN;
            if (r < 2 * I_OUT) { const int j = r / I_OUT; transpose_item(a.in[I_SWOUT] + (size_t)j * 2048 * 1024, 2048, 1024, (bf16_t*)(ws + WS_WOUT) + (size_t)j * 1024 * 2048, scr, r % I_OUT, lane, 0); continue; } r -= 2 * I_OUT;
            if (r < 4 * I_1) { const int j = r / I_1; transpose_item(a.in[I_W1] + (size_t)j * 1024 * 4096, 1024, 4096, (bf16_t*)(ws + WS_W1) + (size_t)j * 4096 * 1024, scr, r % I_1, lane, 0); continue; } r -= 4 * I_1;
            { const int j = r / I_2; transpose_item(a.in[I_W2] + (size_t)j * 4096 * 1024, 4096, 1024, (bf16_t*)(ws + WS_W2) + (size_t)j * 1024 * 4096, scr, r % I_2, lane, 0); }
        }
    }
}

struct RowPass {
    const float* xin_lat; const float* xin_ctx; float* xout_lat;
    const bf16_t* xin_bf; bf16_t* xout_bf;
    const bf16_t* Y; const float* g_post; const float* gate;
    bf16_t* A; const float* g_pre; const float* shift; const float* scale;
    int nrows;
};
constexpr int RP_R = 4;
__device__ __forceinline__ void phase_rowpass(const RowPass& p) {
    int tid_ = threadIdx.x; asm volatile("" : "+v"(tid_)); const int tid = tid_, lane = tid & 63, wave = tid >> 6, G = launder_s(gridDim.x);
    const int gw = launder_s(blockIdx.x) * 8 + wave, NGW = G * 8;
    for (int row0 = gw; row0 < p.nrows; row0 += RP_R * NGW) {
        int rows[RP_R]; bool ok[RP_R];
#pragma unroll
        for (int u = 0; u < RP_R; ++u) { rows[u] = row0 + u * NGW; ok[u] = rows[u] < p.nrows; if (!ok[u]) rows[u] = row0; }
        f32x4 v[RP_R][4]; u32x2 yw[RP_R][4];
#pragma unroll
        for (int u = 0; u < RP_R; ++u) { const int row = rows[u]; const bool lat = row < MLAT;
            if (p.xin_bf) { const bf16_t* xb = p.xin_bf + (size_t)row * D;
#pragma unroll
                for (int j = 0; j < 4; ++j) { const u32x2 w = *(const u32x2*)(xb + 4 * lane + 256 * j); v[u][j] = (f32x4){bf_lo(w.x), bf_hi(w.x), bf_lo(w.y), bf_hi(w.y)}; } }
            else { const float* xr = lat ? p.xin_lat + (size_t)row * D : p.xin_ctx + (size_t)(row - MLAT) * D;
#pragma unroll
                for (int j = 0; j < 4; ++j) v[u][j] = *(const f32x4*)(xr + 4 * lane + 256 * j); }
            if (p.Y) { const bf16_t* yr = p.Y + (size_t)row * D;
#pragma unroll
                for (int j = 0; j < 4; ++j) yw[u][j] = *(const u32x2*)(yr + 4 * lane + 256 * j); } }
#pragma unroll
        for (int u = 0; u < RP_R; ++u) { const int row = rows[u]; const bool lat = row < MLAT; const int bb = lat ? (row >> 13) : 4;
            if (!ok[u]) continue;
            if (p.Y) {
                f32x4 y[4]; float ss = 0.f;
#pragma unroll
                for (int j = 0; j < 4; ++j) { const u32x2 w = yw[u][j]; y[j] = (f32x4){bf_lo(w.x), bf_hi(w.x), bf_lo(w.y), bf_hi(w.y)}; ss += (y[j][0] * y[j][0] + y[j][1] * y[j][1]) + (y[j][2] * y[j][2] + y[j][3] * y[j][3]); }
                const float r = rsqrtf(wave_sum(ss) * (1.f / D) + EPS);
#pragma unroll
                for (int j = 0; j < 4; ++j) { const f32x4 gp = *(const f32x4*)(p.g_post + 4 * lane + 256 * j); const f32x4 gt = *(const f32x4*)(p.gate + (size_t)bb * 6144 + 4 * lane + 256 * j); v[u][j] = v[u][j] + gt * (y[j] * r * gp); }
            }
            if (p.xout_bf) { bf16_t* xb = p.xout_bf + (size_t)row * D;
#pragma unroll
                for (int j = 0; j < 4; ++j) { u32x2 w; w.x = cvt_pk_bf16(v[u][j][0], v[u][j][1]); w.y = cvt_pk_bf16(v[u][j][2], v[u][j][3]); *(u32x2*)(xb + 4 * lane + 256 * j) = w; } }
            if (p.xout_lat && lat) { float* xo = p.xout_lat + (size_t)row * D;
#pragma unroll
                for (int j = 0; j < 4; ++j) *(f32x4*)(xo + 4 * lane + 256 * j) = v[u][j]; }
            if (p.A) {
                float ss = 0.f;
#pragma unroll
                for (int j = 0; j < 4; ++j) ss += (v[u][j][0] * v[u][j][0] + v[u][j][1] * v[u][j][1]) + (v[u][j][2] * v[u][j][2] + v[u][j][3] * v[u][j][3]);
                const float r = rsqrtf(wave_sum(ss) * (1.f / D) + EPS);
                bf16_t* ar = p.A + (size_t)row * D;
#pragma unroll
                for (int j = 0; j < 4; ++j) { const f32x4 gp = *(const f32x4*)(p.g_pre + 4 * lane + 256 * j); const f32x4 sh = *(const f32x4*)(p.shift + (size_t)bb * 6144 + 4 * lane + 256 * j); const f32x4 sc = *(const f32x4*)(p.scale + (size_t)bb * 6144 + 4 * lane + 256 * j);
                    const f32x4 o = (v[u][j] * r * gp) * (sc + 1.f) + sh; u32x2 w; w.x = cvt_pk_bf16(o[0], o[1]); w.y = cvt_pk_bf16(o[2], o[3]); *(u32x2*)(ar + 4 * lane + 256 * j) = w; }
            }
        }
    }
}

constexpr int AT_STAGE = 32768;
__device__ __forceinline__ float swap32_max(float m) { auto rr = __builtin_amdgcn_permlane32_swap(__float_as_uint(m), __float_as_uint(m), false, false); return fmaxf(__uint_as_float(rr[0]), __uint_as_float(rr[1])); }
__device__ __forceinline__ float swap32_sum(float m) { auto rr = __builtin_amdgcn_permlane32_swap(__float_as_uint(m), __float_as_uint(m), false, false); return __uint_as_float(rr[0]) + __uint_as_float(rr[1]); }

__device__ __forceinline__ float at_sub(float a, float b) { return a - b; }
__device__ __forceinline__ float at_add(float a, float b) { return a + b; }
__device__ __forceinline__ void attn_unit(LAS unsigned char* lds, const bf16_t* QKV, bf16_t* O, int qrow0, int b, int h, int nt, float lam, float oscale, const float* subln_g) {
    int tid_ = threadIdx.x; asm volatile("" : "+v"(tid_)); const int tid = tid_, lane = tid & 63, wid = __builtin_amdgcn_readfirstlane(tid >> 6), r32 = lane & 31, hi = lane >> 5;
    const int map = wid >> 2, wq = wid & 3;
    const int lrow = tid >> 4, lch = tid & 15;
    const unsigned gofs = (unsigned)((lrow * QKVW + 1024 + h * 128 + lch * 8) * 2);
    const unsigned koff = (unsigned)((lch >> 3) * 8192 + lrow * 128 + (((lch & 7) ^ ((lrow >> 1) & 7)) << 4));
    const unsigned voff = (unsigned)((lch >> 2) * 4096 + (lrow >> 3) * 512 + (lrow & 7) * 64 + (lch & 3) * 16);
    u32x4 kr[2], vr[2];
#define AT_SB() __builtin_amdgcn_sched_barrier(0)
#define AT_TROW(t) (((t) < 4) ? (size_t)(MLAT + b * CTX + 64 * (t)) : (size_t)(b * SEQ + 64 * ((t) - 4)))
#define AT_GLOAD_K(t) do { const char* tb_ = (const char*)(QKV + AT_TROW(t) * QKVW) + gofs; kr[0] = *(const u32x4*)(tb_); kr[1] = *(const u32x4*)(tb_ + 32 * QKVW * 2); } while (0)
#define AT_GLOAD_V(t) do { const char* tb_ = (const char*)(QKV + AT_TROW(t) * QKVW) + gofs; vr[0] = *(const u32x4*)(tb_ + 2048); vr[1] = *(const u32x4*)(tb_ + 32 * QKVW * 2 + 2048); } while (0)
#define AT_LSTORE_K(so) do { *(LAS u32x4*)(lds + (so) + koff) = kr[0]; *(LAS u32x4*)(lds + (so) + koff + 4096) = kr[1]; } while (0)
#define AT_LSTORE_V(so) do { *(LAS u32x4*)(lds + (so) + voff) = vr[0]; *(LAS u32x4*)(lds + (so) + voff + 2048) = vr[1]; } while (0)
#define AT_MF(a, b, c) __builtin_amdgcn_mfma_f32_32x32x16_bf16((a), (b), (c), 0, 0, 0)
#define AT_KRD(s_) do { const int co_ = ((2 * (s_) + hi) ^ ksw) << 4; k0_[(s_) & 1] = *(const LAS bf16x8*)(kb_ + co_); k1_[(s_) & 1] = *(const LAS bf16x8*)(kb_ + 4096 + co_); } while (0)
#define AT_S(P0, P1, kso) do { LAS const unsigned char* kb_ = lds + (kso) + kbase; bf16x8 k0_[2], k1_[2]; const f32x16 z_ = {0.f,0.f,0.f,0.f,0.f,0.f,0.f,0.f,0.f,0.f,0.f,0.f,0.f,0.f,0.f,0.f}; \
        AT_KRD(0); AT_KRD(1); \
        P0 = AT_MF(k0_[0], qf[0], z_); P1 = AT_MF(k1_[0], qf[0], z_); AT_KRD(2); \
        P0 = AT_MF(k0_[1], qf[1], P0); P1 = AT_MF(k1_[1], qf[1], P1); AT_KRD(3); \
        P0 = AT_MF(k0_[0], qf[2], P0); P1 = AT_MF(k1_[0], qf[2], P1); \
        P0 = AT_MF(k0_[1], qf[3], P0); P1 = AT_MF(k1_[1], qf[3], P1); } while (0)
#define AT_ROWMAX(P0, P1, out) do { float ta_ = fmaxf(fmaxf(P0[0], P0[1]), P1[0]), tb_ = fmaxf(fmaxf(P0[2], P0[3]), P1[1]); ta_ = fmaxf(fmaxf(ta_, P1[2]), P1[3]); \
        _Pragma("unroll") for (int i_ = 4; i_ < 16; i_ += 4) { ta_ = fmaxf(fmaxf(ta_, P0[i_]), P0[i_ + 1]); tb_ = fmaxf(fmaxf(tb_, P0[i_ + 2]), P0[i_ + 3]); ta_ = fmaxf(fmaxf(ta_, P1[i_]), P1[i_ + 1]); tb_ = fmaxf(fmaxf(tb_, P1[i_ + 2]), P1[i_ + 3]); } \
        out = swap32_max(fmaxf(ta_, tb_)); } while (0)
#define AT_VRD(dst, c, kp) do { _Pragma("unroll") for (int k2_ = 0; k2_ < 2; ++k2_) { const int ks_ = 2 * (kp) + k2_; \
        const s16x4 lo_ = __builtin_bit_cast(s16x4, __builtin_amdgcn_ds_read_tr16_b64_v4i16((LAS s16x4*)(vb_ + (c) * 4096 + ks_ * 1024))); \
        const s16x4 hh_ = __builtin_bit_cast(s16x4, __builtin_amdgcn_ds_read_tr16_b64_v4i16((LAS s16x4*)(vb_ + (c) * 4096 + ks_ * 1024 + 512))); \
        dst[k2_] = __builtin_shufflevector(lo_, hh_, 0, 1, 2, 3, 4, 5, 6, 7); } } while (0)
#define AT_PVC(src, c, kp) do { _Pragma("unroll") for (int k2_ = 0; k2_ < 2; ++k2_) o[c] = AT_MF(src[k2_], pf[2 * (kp) + k2_], o[c]); } while (0)
#define AT_PVALL(vso, first_done) do { LAS const unsigned char* vb_ = lds + (vso) + vbase; \
        if (!(first_done)) { AT_VRD(va_, 0, 0); } \
        AT_SB(); AT_VRD(vc_, 0, 1); AT_SB(); AT_PVC(va_, 0, 0); AT_SB(); \
        AT_VRD(va_, 1, 0); AT_SB(); AT_PVC(vc_, 0, 1); AT_SB(); \
        AT_VRD(vc_, 1, 1); AT_SB(); AT_PVC(va_, 1, 0); AT_SB(); \
        AT_VRD(va_, 2, 0); AT_SB(); AT_PVC(vc_, 1, 1); AT_SB(); \
        AT_VRD(vc_, 2, 1); AT_SB(); AT_PVC(va_, 2, 0); AT_SB(); \
        AT_VRD(va_, 3, 0); AT_SB(); AT_PVC(vc_, 2, 1); AT_SB(); \
        AT_VRD(vc_, 3, 1); AT_SB(); AT_PVC(va_, 3, 0); AT_SB(); \
        AT_PVC(vc_, 3, 1); AT_SB(); } while (0)
#define AT_STEP(t, C0, C1, N0, N1, kso_next, kso_store) do { \
        const bool more1_ = (t) + 1 < nt, more2_ = (t) + 2 < nt; bf16x8 va_[2], vc_[2]; \
        if (more2_) AT_GLOAD_K((t) + 2); if (more1_) AT_GLOAD_V((t) + 1); \
        if (map == 1 && (t) > 0) AT_PVALL(vs_prev, false); \
        if (more1_) AT_S(N0, N1, kso_next); \
        float tm_; AT_ROWMAX(C0, C1, tm_); \
        if (__any(tm_ > mrun + 8.0f)) { const float mn_ = fmaxf(tm_, mrun); const float al_ = __builtin_amdgcn_exp2f(mrun - mn_); mrun = mn_; lrun *= al_; \
            _Pragma("unroll") for (int c_ = 0; c_ < 4; ++c_) _Pragma("unroll") for (int i_ = 0; i_ < 16; ++i_) o[c_][i_] *= al_; } \
        if (map == 0) { LAS const unsigned char* vb_ = lds + vs_cur + vbase; AT_VRD(va_, 0, 0); } AT_SB(); \
        float sacc_ = 0.f; \
        _Pragma("unroll") for (int i_ = 0; i_ < 16; i_ += 2) { C0[i_] = __builtin_amdgcn_exp2f(at_sub(C0[i_], mrun)); C0[i_ + 1] = __builtin_amdgcn_exp2f(at_sub(C0[i_ + 1], mrun)); C1[i_] = __builtin_amdgcn_exp2f(at_sub(C1[i_], mrun)); C1[i_ + 1] = __builtin_amdgcn_exp2f(at_sub(C1[i_ + 1], mrun)); \
            sacc_ += C0[i_]; sacc_ += C0[i_ + 1]; sacc_ += C1[i_]; sacc_ += C1[i_ + 1]; asm volatile("" : "+v"(sacc_)); } \
        lrun += sacc_; \
        { u32x4 w_; \
          w_.x = cvt_pk_bf16(C0[0], C0[1]); w_.y = cvt_pk_bf16(C0[2], C0[3]); w_.z = cvt_pk_bf16(C0[4], C0[5]); w_.w = cvt_pk_bf16(C0[6], C0[7]); pf[0] = __builtin_bit_cast(bf16x8, w_); \
          w_.x = cvt_pk_bf16(C0[8], C0[9]); w_.y = cvt_pk_bf16(C0[10], C0[11]); w_.z = cvt_pk_bf16(C0[12], C0[13]); w_.w = cvt_pk_bf16(C0[14], C0[15]); pf[1] = __builtin_bit_cast(bf16x8, w_); \
          w_.x = cvt_pk_bf16(C1[0], C1[1]); w_.y = cvt_pk_bf16(C1[2], C1[3]); w_.z = cvt_pk_bf16(C1[4], C1[5]); w_.w = cvt_pk_bf16(C1[6], C1[7]); pf[2] = __builtin_bit_cast(bf16x8, w_); \
          w_.x = cvt_pk_bf16(C1[8], C1[9]); w_.y = cvt_pk_bf16(C1[10], C1[11]); w_.z = cvt_pk_bf16(C1[12], C1[13]); w_.w = cvt_pk_bf16(C1[14], C1[15]); pf[3] = __builtin_bit_cast(bf16x8, w_); } \
        if (map == 0) AT_PVALL(vs_cur, true); \
        if (more2_) AT_LSTORE_K(kso_store); if (more1_) AT_LSTORE_V(vs_next); \
        __syncthreads(); \
        vs_prev = vs_cur; vs_cur = vs_next; vs_next = (vs_next == 32768 + 2 * 16384) ? 32768 : vs_next + 16384; } while (0)

    const int kbase = map * 8192 + r32 * 128; const int ksw = (r32 >> 1) & 7;
    const int vbase = ((lane >> 4) & 1) * 32 + (lane & 3) * 8 + (4 * hi + ((lane & 15) >> 2)) * 64;
    AT_GLOAD_K(0); AT_GLOAD_V(0);
    bf16x8 qf[4];
    { const bf16_t* qp = QKV + (size_t)(qrow0 + wq * 32 + r32) * QKVW + h * 128 + map * 64 + hi * 8;
#pragma unroll
      for (int s = 0; s < 4; ++s) qf[s] = *(const bf16x8*)(qp + 16 * s); }
    AT_LSTORE_K(0); AT_LSTORE_V(32768);
    AT_GLOAD_K(1); AT_LSTORE_K(16384);
    __syncthreads();
    f32x16 o[4], pA0, pA1, pB0, pB1;
#pragma unroll
    for (int c = 0; c < 4; ++c)
#pragma unroll
        for (int i = 0; i < 16; ++i) o[c][i] = 0.f;
#pragma unroll
    for (int i = 0; i < 16; ++i) { pB0[i] = 0.f; pB1[i] = 0.f; }
    bf16x8 pf[4];
    float mrun, lrun = 0.f;
    int vs_prev = 32768 + 2 * 16384, vs_cur = 32768, vs_next = 32768 + 16384;
    AT_S(pA0, pA1, 0);
    { float tm0; AT_ROWMAX(pA0, pA1, tm0); mrun = tm0; }
    asm volatile("s_nop 7\n\ts_nop 7" ::: "memory");
    __syncthreads();
    for (int it = 0; it < nt; it += 2) {
        AT_STEP(it,     pA0, pA1, pB0, pB1, 16384, 0);
        AT_STEP(it + 1, pB0, pB1, pA0, pA1, 0,     16384);
    }
    if (map == 1) { bf16x8 va_[2], vc_[2]; AT_PVALL(vs_prev, false); }
    __syncthreads();
#undef AT_SB
#undef AT_TROW
#undef AT_GLOAD_K
#undef AT_GLOAD_V
#undef AT_LSTORE_K
#undef AT_LSTORE_V
#undef AT_MF
#undef AT_S
#undef AT_KRD
#undef AT_ROWMAX
#undef AT_VRD
#undef AT_PVC
#undef AT_PVALL
#undef AT_STEP
    const float inv = 1.f / swap32_sum(lrun);
    LAS float* ex = (LAS float*)lds;
    if (map == 1) {
#pragma unroll
        for (int c = 0; c < 4; ++c)
#pragma unroll
            for (int i = 0; i < 16; ++i) ex[((wq * 64) + c * 16 + i) * 64 + lane] = o[c][i] * inv;
    }
    __syncthreads();
    if (map == 0) {
        float ss = 0.f;
#pragma unroll
        for (int c = 0; c < 4; ++c)
#pragma unroll
            for (int i = 0; i < 16; ++i) { const float v = o[c][i] * inv - lam * ex[((wq * 64) + c * 16 + i) * 64 + lane]; o[c][i] = v; ss += v * v; }
        ss = swap32_sum(ss);
        const float r = rsqrtf(ss * (1.f / 128.f) + EPS) * oscale;
        bf16_t* op = O + (size_t)(qrow0 + wq * 32 + r32) * D + h * 128;
#pragma unroll
        for (int c = 0; c < 4; ++c)
#pragma unroll
            for (int g4 = 0; g4 < 4; ++g4) { const int d = 32 * c + 8 * g4 + 4 * hi; const f32x4 gv = *(const f32x4*)(subln_g + d);
                u32x2 w; w.x = cvt_pk_bf16(o[c][4 * g4] * r * gv[0], o[c][4 * g4 + 1] * r * gv[1]); w.y = cvt_pk_bf16(o[c][4 * g4 + 2] * r * gv[2], o[c][4 * g4 + 3] * r * gv[3]);
                *(u32x2*)(op + d) = w; }
    }
    __syncthreads();
}

__device__ __forceinline__ void phase_attention(const Args& a, LAS unsigned char* lds, int layer, bool ctx_queries) {
    int tid_ = threadIdx.x; asm volatile("" : "+v"(tid_)); const int G = launder_s(gridDim.x), bx = launder_s(blockIdx.x), lane = tid_ & 63;
    const int j = layer >> 1;
    const float lam_init = (layer == 0) ? 0.2f : 0.47071301f;
    const float* lp = a.in[I_LAMBDA] + j * 256;
    const float s1 = wave_sum(lp[lane] * lp[64 + lane]), s2 = wave_sum(lp[128 + lane] * lp[192 + lane]);
    const float lam = expf(s1) - expf(s2) + lam_init;
    const float oscale = 1.f - lam_init;
    const bf16_t* QKV = (const bf16_t*)(a.ws + WS_BIG); bf16_t* O = (bf16_t*)(a.ws + WS_BIG + (size_t)MALL * QKVW * 2);
    const float* sg = a.in[I_SUBLN] + j * 128;
    if (G == 256) {
        const int vcu = (bx % 8) * 32 + bx / 8;
        for (int i = 0; i < 8; ++i) { const int bh = (vcu >> 5) * 4 + (i >> 1), qb = (i & 1) * 32 + (vcu & 31); const int b = bh >> 3, h = bh & 7;
            attn_unit(lds, QKV, O, b * SEQ + qb * 128, b, h, 132, lam, oscale, sg); }
    } else {
        for (int idx = bx; idx < 2048; idx += G) { const int bh = idx >> 6, qb = idx & 63; const int b = bh >> 3, h = bh & 7;
            attn_unit(lds, QKV, O, b * SEQ + qb * 128, b, h, 132, lam, oscale, sg); }
    }
    if (ctx_queries) {
        for (int idx = bx; idx < 64; idx += G) { const int bh = idx >> 1, qb = idx & 1; const int b = bh >> 3, h = bh & 7;
            attn_unit(lds, QKV, O, MLAT + b * CTX + qb * 128, b, h, 4, lam, oscale, sg); }
    }
}

__device__ __forceinline__ void phase_lnstats(const Args& a, int nrows) {
    int tid_ = threadIdx.x; asm volatile("" : "+v"(tid_)); const int tid = tid_, lane = tid & 63, wave = tid >> 6, G = launder_s(gridDim.x);
    const int gw = launder_s(blockIdx.x) * 8 + wave, NGW = G * 8;
    const bf16_t* Z = (const bf16_t*)(a.ws + WS_BIG); float* st = (float*)(a.ws + WS_LNST);
    for (int row0 = gw; row0 < nrows; row0 += 2 * NGW) {
        u32x4 w[2][4]; int rows[2]; rows[0] = row0; rows[1] = row0 + NGW; const bool ok1 = rows[1] < nrows; if (!ok1) rows[1] = row0;
#pragma unroll
        for (int u = 0; u < 2; ++u) { const bf16_t* zr = Z + (size_t)rows[u] * SGUW + SGUH;
#pragma unroll
            for (int j = 0; j < 4; ++j) w[u][j] = *(const u32x4*)(zr + 8 * lane + 512 * j); }
#pragma unroll
        for (int u = 0; u < 2; ++u) { if (u == 1 && !ok1) continue;
            float v[32]; float s = 0.f;
#pragma unroll
            for (int j = 0; j < 4; ++j) { const u32x4 x = w[u][j];
                v[8 * j + 0] = bf_lo(x.x); v[8 * j + 1] = bf_hi(x.x); v[8 * j + 2] = bf_lo(x.y); v[8 * j + 3] = bf_hi(x.y); v[8 * j + 4] = bf_lo(x.z); v[8 * j + 5] = bf_hi(x.z); v[8 * j + 6] = bf_lo(x.w); v[8 * j + 7] = bf_hi(x.w); }
#pragma unroll
            for (int i = 0; i < 32; ++i) s += v[i];
            const float mu = wave_sum(s) * (1.f / SGUH); float q = 0.f;
#pragma unroll
            for (int i = 0; i < 32; ++i) { const float d = v[i] - mu; q += d * d; }
            const float rstd = rsqrtf(wave_sum(q) * (1.f / SGUH) + EPS);
            if (lane == 0) { st[2 * rows[u]] = mu; st[2 * rows[u] + 1] = rstd; } }
    }
}

__device__ __forceinline__ void phase_spatial(const Args& a, LAS unsigned char* lds, int j, int nchunks) {
    int tid_ = threadIdx.x; asm volatile("" : "+v"(tid_)); const int tid = tid_, lane = tid & 63, wid = __builtin_amdgcn_readfirstlane(tid >> 6), r32 = lane & 31, hi = lane >> 5, G = launder_s(gridDim.x);
    bf16_t* Z = (bf16_t*)(a.ws + WS_BIG); const float* st = (const float*)(a.ws + WS_LNST);
    const bf16_t* wsb = (const bf16_t*)(a.ws + WS_WS) + (size_t)j * 8 * 16384;
    const float* lng = a.in[I_SLNG] + j * SGUH; const float* lnb = a.in[I_SLNB] + j * SGUH; const float* bs = a.in[I_SBS] + j * 8 * 128;
    LAS unsigned char* vt = lds;
    LAS unsigned char* wl = lds + 67584;
    int gcur = -1;
    const int lch = tid & 31, lrow = tid >> 5;
    for (int idx = launder_s(blockIdx.x); idx < nchunks * 8; idx += G) {
        const int chunk = idx >> 3, g = idx & 7; const size_t row0 = (size_t)chunk * 128;
        if (g != gcur) {
#pragma unroll
            for (int p = 0; p < 4; ++p) { const int i = tid + 512 * p; const int row = i >> 4, ch = i & 15; const u32x4 w = *(const u32x4*)(wsb + (size_t)g * 16384 + row * 128 + ch * 8);
                *(LAS u32x4*)(wl + row * 256 + ((ch ^ (row & 15)) << 4)) = w; }
            gcur = g;
        }
        {
            f32x4 g0 = *(const f32x4*)(lng + g * 256 + lch * 8), g1 = *(const f32x4*)(lng + g * 256 + lch * 8 + 4), b0 = *(const f32x4*)(lnb + g * 256 + lch * 8), b1 = *(const f32x4*)(lnb + g * 256 + lch * 8 + 4);
#pragma unroll
            for (int p = 0; p < 8; ++p) { const int row = lrow + 16 * p; const u32x4 w = *(const u32x4*)(Z + (row0 + row) * SGUW + SGUH + g * 256 + lch * 8);
                const f32x2 ms = *(const f32x2*)(st + 2 * (row0 + row));
                f32x4 x0 = {bf_lo(w.x), bf_hi(w.x), bf_lo(w.y), bf_hi(w.y)}, x1 = {bf_lo(w.z), bf_hi(w.z), bf_lo(w.w), bf_hi(w.w)};
                x0 = (x0 - ms.x) * ms.y * g0 + b0; x1 = (x1 - ms.x) * ms.y * g1 + b1;
                u32x4 o; o.x = cvt_pk_bf16(x0[0], x0[1]); o.y = cvt_pk_bf16(x0[2], x0[3]); o.z = cvt_pk_bf16(x1[0], x1[1]); o.w = cvt_pk_bf16(x1[2], x1[3]);
                *(LAS u32x4*)(vt + (lch >> 2) * 8192 + (row >> 3) * 512 + (row & 7) * 64 + (lch & 3) * 16) = o; }
        }
        __syncthreads();
        u32x4 uu[8];
#pragma unroll
        for (int p8 = 0; p8 < 8; ++p8) { const int row = lrow + 16 * p8; uu[p8] = *(const u32x4*)(Z + (row0 + row) * SGUW + g * 256 + lch * 8); }
        f32x16 acc[4];
#pragma unroll
        for (int pb = 0; pb < 4; ++pb)
#pragma unroll
            for (int i = 0; i < 16; ++i) acc[pb][i] = 0.f;
        const int vb = wid * 8192 + ((lane >> 4) & 1) * 32 + (lane & 3) * 8 + ((lane & 15) >> 2) * 64;
#pragma unroll
        for (int ks = 0; ks < 8; ++ks) {
            const s16x4 lo = __builtin_bit_cast(s16x4, __builtin_amdgcn_ds_read_tr16_b64_v4i16((LAS s16x4*)(vt + vb + (2 * ks + hi) * 512)));
            const s16x4 hh = __builtin_bit_cast(s16x4, __builtin_amdgcn_ds_read_tr16_b64_v4i16((LAS s16x4*)(vt + vb + (2 * ks + hi) * 512 + 256)));
            const bf16x8 vf = __builtin_shufflevector(lo, hh, 0, 1, 2, 3, 4, 5, 6, 7);
#pragma unroll
            for (int pb = 0; pb < 4; ++pb) { const int row = 32 * pb + r32; const bf16x8 wf = *(const LAS bf16x8*)(wl + row * 256 + (((2 * ks + hi) ^ (row & 15)) << 4));
                acc[pb] = __builtin_amdgcn_mfma_f32_32x32x16_bf16(vf, wf, acc[pb], 0, 0, 0); }
        }
        __syncthreads();
#pragma unroll
        for (int pb = 0; pb < 4; ++pb) { const int p = 32 * pb + r32; const float bias = bs[g * 128 + p];
#pragma unroll
            for (int g4 = 0; g4 < 4; ++g4) { u32x2 w; w.x = cvt_pk_bf16(acc[pb][4 * g4] + bias, acc[pb][4 * g4 + 1] + bias); w.y = cvt_pk_bf16(acc[pb][4 * g4 + 2] + bias, acc[pb][4 * g4 + 3] + bias);
                *(LAS u32x2*)(vt + p * 520 + (32 * wid + 8 * g4 + 4 * hi) * 2) = w; } }
        __syncthreads();
        {
#pragma unroll
          for (int p8 = 0; p8 < 8; ++p8) { const int row = lrow + 16 * p8; const u32x2 s0 = *(const LAS u32x2*)(vt + row * 520 + lch * 16), s1 = *(const LAS u32x2*)(vt + row * 520 + lch * 16 + 8);
              u32x4 o; o.x = cvt_pk_bf16(bf_lo(uu[p8].x) * bf_lo(s0.x), bf_hi(uu[p8].x) * bf_hi(s0.x)); o.y = cvt_pk_bf16(bf_lo(uu[p8].y) * bf_lo(s0.y), bf_hi(uu[p8].y) * bf_hi(s0.y));
              o.z = cvt_pk_bf16(bf_lo(uu[p8].z) * bf_lo(s1.x), bf_hi(uu[p8].z) * bf_hi(s1.x)); o.w = cvt_pk_bf16(bf_lo(uu[p8].w) * bf_lo(s1.y), bf_hi(uu[p8].w) * bf_hi(s1.y));
              *(u32x4*)(Z + (row0 + row) * SGUW + g * 256 + lch * 8) = o; } }
        __syncthreads();
    }
}

__device__ __forceinline__ void ctx_gemm(LAS unsigned char* lds, const bf16_t* A, int lda, const bf16_t* Bt, int K, bf16_t* Y) {
    int tid_ = threadIdx.x; asm volatile("" : "+v"(tid_)); const int tid = tid_, lane = tid & 63, wid = __builtin_amdgcn_readfirstlane(tid >> 6), fr = lane & 15, fq = lane >> 4;
    LAS f32x4* red = (LAS f32x4*)lds;
    const int G = launder_s(gridDim.x);
    for (int idx = launder_s(blockIdx.x); idx < 256; idx += G) {
        const int tm = idx >> 4, tn = idx & 15, kw = K >> 3;
        const bf16_t* ap = A + (size_t)(MLAT + tm * 64 + fr) * lda + wid * kw + 8 * fq;
        const bf16_t* bp = Bt + (size_t)(tn * 64 + fr) * K + wid * kw + 8 * fq;
        f32x4 acc[4][4];
#pragma unroll
        for (int i = 0; i < 4; ++i)
#pragma unroll
            for (int j = 0; j < 4; ++j) acc[i][j] = (f32x4){0.f, 0.f, 0.f, 0.f};
        for (int k0 = 0; k0 < kw; k0 += 64) {
            bf16x8 af[2][4], bf[2][4];
#pragma unroll
            for (int u = 0; u < 2; ++u)
#pragma unroll
                for (int i = 0; i < 4; ++i) { af[u][i] = *(const bf16x8*)(ap + (size_t)(16 * i) * lda + k0 + 32 * u); bf[u][i] = *(const bf16x8*)(bp + (size_t)(16 * i) * K + k0 + 32 * u); }
#pragma unroll
            for (int u = 0; u < 2; ++u)
#pragma unroll
                for (int i = 0; i < 4; ++i)
#pragma unroll
                    for (int j = 0; j < 4; ++j) acc[i][j] = __builtin_amdgcn_mfma_f32_16x16x32_bf16(bf[u][j], af[u][i], acc[i][j], 0, 0, 0);
        }
#pragma unroll
        for (int half = 4; half >= 1; half >>= 1) {
            if (wid >= half && wid < 2 * half) {
#pragma unroll
                for (int i = 0; i < 4; ++i)
#pragma unroll
                    for (int j = 0; j < 4; ++j) red[((wid - half) * 16 + i * 4 + j) * 64 + lane] = acc[i][j]; }
            __syncthreads();
            if (wid < half) {
#pragma unroll
                for (int i = 0; i < 4; ++i)
#pragma unroll
                    for (int j = 0; j < 4; ++j) acc[i][j] = acc[i][j] + red[(wid * 16 + i * 4 + j) * 64 + lane]; }
            __syncthreads();
        }
        if (wid == 0) {
#pragma unroll
            for (int i = 0; i < 4; ++i) { bf16_t* yp = Y + (size_t)(MLAT + tm * 64 + 16 * i + fr) * D + tn * 64 + 4 * fq;
#pragma unroll
                for (int j = 0; j < 4; ++j) { u32x2 w; w.x = cvt_pk_bf16(acc[i][j][0], acc[i][j][1]); w.y = cvt_pk_bf16(acc[i][j][2], acc[i][j][3]); *(u32x2*)(yp + 16 * j) = w; } }
        }
    }
}

#define XB_TMO      128
#define XB_XCNT(j)  (256  + 64 * (j))
#define XB_XSUB(j)  (1280 + 64 * (j))
#define XB_XGEN(j)  (2304 + 64 * (j))
#define XB_TOP      3328
#define XB_TOPGEN   3392
#define XCD_BAR_WORDS 3456
#define XB_SPIN_CAP (1u << 22)
__device__ __forceinline__ unsigned xb_ld(unsigned* p)              { return __hip_atomic_load(p, __ATOMIC_RELAXED, __HIP_MEMORY_SCOPE_AGENT); }
__device__ __forceinline__ unsigned xb_add(unsigned* p, unsigned v) { return __hip_atomic_fetch_add(p, v, __ATOMIC_RELAXED, __HIP_MEMORY_SCOPE_AGENT); }
__device__ __forceinline__ unsigned xb_xcc_id() { return (unsigned)__builtin_amdgcn_s_getreg((3 << 11) | 20) & 0xFu; }
#define XB_SPIN(cond, bar) do { unsigned _sp = 0; while (cond) { __builtin_amdgcn_s_sleep(1); \
    if ((++_sp & 255u) == 0u) { if (xb_ld(&(bar)[XB_TMO])) break; if (_sp > XB_SPIN_CAP) { atomicAdd(&(bar)[XB_TMO], 1u); break; } } } } while (0)
struct XcdBarrier { unsigned* bar; unsigned x; volatile LAS unsigned* st; };
__device__ __forceinline__ XcdBarrier xcd_barrier_post(unsigned* bar, volatile LAS unsigned* st) {
    XcdBarrier b; b.bar = bar; b.x = xb_xcc_id(); b.st = st;
    int t0_ = threadIdx.x; asm volatile("" : "+v"(t0_));
    if (t0_ == 0) (void)xb_add(&bar[XB_XCNT(b.x)], 1u);
    return b;
}
__device__ __forceinline__ void xcd_barrier_complete(unsigned* bar, unsigned x, unsigned& nloc, unsigned& nx) {
    const unsigned G = gridDim.x * gridDim.y * gridDim.z;
    unsigned sum, cnt, mine, sp = 0u;
    for (;;) {
        sum = 0u; cnt = 0u; mine = 0u;
#pragma unroll
        for (unsigned j = 0; j < 16; ++j) { const unsigned c = xb_ld(&bar[XB_XCNT(j)]); sum += c; cnt += (c > 0u) ? 1u : 0u; mine = (j == x) ? c : mine; }
        if (sum == G) break;
        __builtin_amdgcn_s_sleep(1);
        if ((++sp & 255u) == 0u) { if (xb_ld(&bar[XB_TMO])) break; if (sp > XB_SPIN_CAP) { atomicAdd(&bar[XB_TMO], 1u); break; } }
    }
    nloc = mine > 0u ? mine : 1u; nx = cnt > 0u ? cnt : 1u;
}
__device__ __forceinline__ void xcd_barrier(const XcdBarrier& b) {
    asm volatile("s_waitcnt vmcnt(0)" ::: "memory");
    __syncthreads();
    int t0_ = threadIdx.x; asm volatile("" : "+v"(t0_));
    if (t0_ == 0) {
        unsigned* bar = b.bar;
        __builtin_amdgcn_s_waitcnt(0);
        unsigned nloc = b.st[0], nx = b.st[1];
        if (nloc == 0u) { xcd_barrier_complete(bar, b.x, nloc, nx); b.st[0] = nloc; b.st[1] = nx; }
        const unsigned old = xb_add(&bar[XB_XSUB(b.x)], 1u);
        const unsigned gen = old / nloc;
        if (old + 1u == (gen + 1u) * nloc) {
            __builtin_amdgcn_fence(__ATOMIC_RELEASE, "agent");
            asm volatile("s_waitcnt vmcnt(0)" ::: "memory");
            const unsigned og = xb_add(&bar[XB_TOP], 1u);
            const unsigned tg = og / nx;
            if (og + 1u == (tg + 1u) * nx) xb_add(&bar[XB_TOPGEN], 1u);
            else XB_SPIN(xb_ld(&bar[XB_TOPGEN]) == tg, bar);
            __builtin_amdgcn_fence(__ATOMIC_ACQUIRE, "agent");
            xb_add(&bar[XB_XGEN(b.x)], 1u);
            asm volatile("s_waitcnt vmcnt(0)" ::: "memory");
        } else {
            XB_SPIN(xb_ld(&bar[XB_XGEN(b.x)]) == gen, bar);
            __builtin_amdgcn_fence(__ATOMIC_ACQUIRE, "agent");
            asm volatile("s_waitcnt vmcnt(0)" ::: "memory");
        }
    }
    __syncthreads();
}

constexpr int LDS_BYTES = 147456;
constexpr int NPHASES = 32;
#ifndef MK_MASK
#define MK_MASK 0xffff
#endif
#define EN(b) ((MK_MASK >> (b)) & 1)
#ifndef MK_DUP
#define MK_DUP 0
#endif
#define DUP(b) ((MK_DUP >> (b)) & 1)

__global__ void __launch_bounds__(512) fwd_megakernel(Args a) {
    extern __shared__ __attribute__((aligned(16))) unsigned char lds_raw[];
    LAS unsigned char* lds = (LAS unsigned char*)lds_raw;
    cg::grid_group grid = cg::this_grid();
    unsigned char* ws = a.ws;
    const float* mod = (const float*)(ws + WS_MOD);
    const float* normg = a.in[I_NORMG];
    bf16_t* Xbf = (bf16_t*)(ws + WS_Y);
    bf16_t* Abuf = (bf16_t*)(ws + WS_A); bf16_t* Ybuf = Abuf; bf16_t* Big = (bf16_t*)(ws + WS_BIG);
    bf16_t* Obuf = (bf16_t*)(ws + WS_BIG + (size_t)MALL * QKVW * 2);

    volatile LAS unsigned* bst = (volatile LAS unsigned*)(lds + 131072 + 1024);
    if (threadIdx.x == 0) { bst[0] = 0u; bst[1] = 0u; }
    __syncthreads();
    XcdBarrier xbar; xbar.bar = (unsigned*)ws; xbar.x = 0; xbar.st = bst;
    for (int ph = a.ph_lo; ph < a.ph_hi; ++ph) {
        asm volatile("" : "+s"(ws));
        const int G = launder_s(gridDim.x), bxl = launder_s(blockIdx.x);
        if (ph == 0) {
            if (bxl == 0) { int t0_ = threadIdx.x; asm volatile("" : "+v"(t0_)); for (int i = t0_; i < XCD_BAR_WORDS; i += 512) __hip_atomic_store((unsigned*)a.ws + i, 0u, __ATOMIC_RELAXED, __HIP_MEMORY_SCOPE_AGENT); }
            if (EN(0)) phase_prologue(a, lds);
            if (DUP(0)) { __syncthreads(); phase_prologue(a, lds); }
        } else if (ph == 1) {
            RowPass p{}; p.xin_lat = a.in[I_X]; p.xin_ctx = a.in[I_CTX]; p.xout_lat = nullptr; p.xin_bf = nullptr; p.xout_bf = nullptr; p.Y = nullptr; p.g_post = nullptr; p.gate = nullptr;
            p.A = Abuf; p.g_pre = normg + 0 * 4096 + 0 * 1024; p.shift = mod + 0; p.scale = mod + 1024; p.nrows = MALL;
            if (EN(1)) phase_rowpass(p);
        } else {
            int layer, k;
            if (ph < 9) { layer = 0; k = ph - 2; } else if (ph < 17) { layer = 1; k = ph - 9; } else if (ph < 24) { layer = 2; k = ph - 17; } else { layer = 3; k = ph - 24; }
            const bool attn = (layer & 1) == 0; const int j = layer >> 1;
            int kind = attn ? (k == 0 ? 0 : k == 1 ? 1 : k + 1) : k;
            const bool ctx_all = layer < 2;
            const int Mfull = ctx_all ? MALL : MLAT;
            const float* lmod = mod + (size_t)layer * 5 * 6144; const float* lg = normg + layer * 4096;
            const bf16_t* cgA = nullptr; const bf16_t* cgB = nullptr; int cgLda = 0, cgK = 0;
            if (kind == 0) {
                if (attn) { pg8::Gemm g{Abuf, (const bf16_t*)(ws + WS_WQKV) + (size_t)j * QKVW * D, (layer == 2) ? MALL : Mfull, QKVW, D, D}; pg8::StaticOrder S; S.init(g.M, g.N, G, bxl);
                    pg8::EpiQKV E{Big, (const float*)(ws + WS_ROPE)}; if (EN(2)) pg8::gemm_phase<pg8::EpiQKV>(lds, g, S, E); if (DUP(2)) pg8::gemm_phase<pg8::EpiQKV>(lds, g, S, E); }
                else { pg8::Gemm g{Abuf, (const bf16_t*)(ws + WS_WIN) + (size_t)j * SGUW * D, Mfull, SGUW, D, D}; pg8::StaticOrder S; S.init(g.M, g.N, G, bxl);
                    pg8::EpiBf16<1> E{Big, SGUW, a.in[I_SBIN] + j * SGUW}; if (EN(3)) pg8::gemm_phase<pg8::EpiBf16<1>>(lds, g, S, E); if (DUP(3)) pg8::gemm_phase<pg8::EpiBf16<1>>(lds, g, S, E); }
            } else if (kind == 1) {
                if (attn) { if (EN(6)) phase_attention(a, lds, layer, layer == 0); if (DUP(6)) { __syncthreads(); phase_attention(a, lds, layer, layer == 0); } }
                else { if (EN(7)) phase_lnstats(a, Mfull); }
            } else if (kind == 2) {
                if (EN(8)) phase_spatial(a, lds, j, Mfull / 128);
            } else if (kind == 3) {
                if (attn) { pg8::Gemm g{Obuf, (const bf16_t*)(ws + WS_WO) + (size_t)j * D * D, MLAT, D, D, D}; pg8::StaticOrder S; S.init(g.M, g.N, G, bxl);
                    pg8::EpiBf16<0> E{Ybuf, D, nullptr}; if (EN(4)) pg8::gemm_phase<pg8::EpiBf16<0>>(lds, g, S, E); if (DUP(4)) pg8::gemm_phase<pg8::EpiBf16<0>>(lds, g, S, E); }
                else { pg8::Gemm g{Big, (const bf16_t*)(ws + WS_WOUT) + (size_t)j * D * SGUH, MLAT, D, SGUH, SGUW}; pg8::StaticOrder S; S.init(g.M, g.N, G, bxl);
                    pg8::EpiBf16<0> E{Ybuf, D, nullptr}; if (EN(4)) pg8::gemm_phase<pg8::EpiBf16<0>>(lds, g, S, E); if (DUP(4)) pg8::gemm_phase<pg8::EpiBf16<0>>(lds, g, S, E); }
                if (ctx_all) {
                    if (attn) { cgA = Obuf; cgLda = D; cgB = (const bf16_t*)(ws + WS_WO) + (size_t)j * D * D; cgK = D; }
                    else { cgA = Big; cgLda = SGUW; cgB = (const bf16_t*)(ws + WS_WOUT) + (size_t)j * D * SGUH; cgK = SGUH; } }
            } else if (kind == 4) {
                RowPass p{}; const bool first = (layer == 0);
                p.xin_lat = a.in[I_X]; p.xin_ctx = a.in[I_CTX]; p.xin_bf = first ? nullptr : Xbf; p.xout_lat = nullptr; p.xout_bf = Xbf;
                p.Y = Ybuf; p.g_post = lg + 1024; p.gate = lmod + 2 * 1024;
                p.A = Abuf; p.g_pre = lg + 2048; p.shift = lmod + 3 * 1024; p.scale = lmod + 4 * 1024; p.nrows = Mfull;
                if (EN(1)) phase_rowpass(p);
            } else if (kind == 5) {
                pg8::Gemm g{Abuf, (const bf16_t*)(ws + WS_W1) + (size_t)layer * FF * D, Mfull, FF, D, D}; pg8::StaticOrder S; S.init(g.M, g.N, G, bxl);
                pg8::EpiBf16<2> E{Big, FF, nullptr}; if (EN(5)) pg8::gemm_phase<pg8::EpiBf16<2>>(lds, g, S, E); if (DUP(5)) pg8::gemm_phase<pg8::EpiBf16<2>>(lds, g, S, E);
            } else if (kind == 6) {
                pg8::Gemm g{Big, (const bf16_t*)(ws + WS_W2) + (size_t)layer * D * FF, MLAT, D, FF, FF}; pg8::StaticOrder S; S.init(g.M, g.N, G, bxl, 1);
                pg8::EpiBf16<0> E{Ybuf, D, nullptr}; if (EN(4)) pg8::gemm_phase<pg8::EpiBf16<0>>(lds, g, S, E); if (DUP(4)) pg8::gemm_phase<pg8::EpiBf16<0>>(lds, g, S, E);
                if (ctx_all) { cgA = Big; cgLda = FF; cgB = (const bf16_t*)(ws + WS_W2) + (size_t)layer * D * FF; cgK = FF; }
            } else {
                RowPass p{}; p.xin_lat = nullptr; p.xin_ctx = nullptr; p.xin_bf = Xbf; p.xout_lat = (layer == 3) ? a.out : nullptr; p.xout_bf = (layer == 3) ? nullptr : Xbf;
                p.Y = Ybuf; p.g_post = lg + 3072; p.gate = lmod + 5 * 1024;
                if (layer < 3) { const float* nmod = mod + (size_t)(layer + 1) * 5 * 6144; p.A = Abuf; p.g_pre = normg + (layer + 1) * 4096; p.shift = nmod; p.scale = nmod + 1024; }
                else { p.A = nullptr; p.g_pre = nullptr; p.shift = nullptr; p.scale = nullptr; }
                p.nrows = (layer == 1) ? MALL : Mfull;
                if (EN(1)) phase_rowpass(p);
            }
            if (cgK) ctx_gemm(lds, cgA, cgLda, cgB, cgK, Ybuf);
        }
        if (ph + 1 < a.ph_hi) {
            if (ph == 0) { grid.sync(); xbar = xcd_barrier_post((unsigned*)a.ws, bst); }
            else { xcd_barrier(xbar); if (DUP(15)) { xcd_barrier(xbar); xcd_barrier(xbar); } }
        }
    }
}

#ifndef MK_PER_PHASE
#define MK_PER_PHASE 0
#endif
extern "C" void kernel_launch(void* const* d_in, const int* in_sizes, int n_in, void* d_out, int out_size, void* d_ws, size_t ws_size, hipStream_t stream) {
    static int grid = 0;
    if (grid == 0) {
        if (n_in != 20 || in_sizes[0] != MLAT * D || out_size != MLAT * D || ws_size < WS_END) {
            fprintf(stderr, "kernel_launch: unexpected shapes: n_in %d in0 %d out %d ws %zu (need %zu)\n", n_in, n_in > 0 ? in_sizes[0] : -1, out_size, ws_size, (size_t)WS_END); grid = -1; return; }
        int dev = 0, cus = 0, per_cu = 0;
        hipGetDevice(&dev); hipDeviceGetAttribute(&cus, hipDeviceAttributeMultiprocessorCount, dev);
        if (hipFuncSetAttribute((const void*)fwd_megakernel, hipFuncAttributeMaxDynamicSharedMemorySize, LDS_BYTES) != hipSuccess) { fprintf(stderr, "kernel_launch: hipFuncSetAttribute failed\n"); grid = -1; return; }
        if (hipOccupancyMaxActiveBlocksPerMultiprocessor(&per_cu, (const void*)fwd_megakernel, 512, LDS_BYTES) != hipSuccess || per_cu < 1) { fprintf(stderr, "kernel_launch: occupancy query says %d\n", per_cu); per_cu = 1; }
        (void)hipGetLastError();
        grid = cus * (per_cu > 1 ? 1 : per_cu);
        fprintf(stderr, "kernel_launch: grid %d (cus %d, per_cu %d)\n", grid, cus, per_cu);
    }
    if (grid < 0) return;
    Args a{};
    for (int i = 0; i < 20; ++i) a.in[i] = (const float*)d_in[i];
    a.out = (float*)d_out; a.ws = (unsigned char*)d_ws;
#if MK_PER_PHASE
    for (int ph = 0; ph < NPHASES; ++ph) { a.ph_lo = ph; a.ph_hi = ph + 1; hipLaunchKernelGGL(fwd_megakernel, dim3(grid), dim3(512), LDS_BYTES, stream, a); }
#else
    a.ph_lo = 0; a.ph_hi = NPHASES;
    void* args[] = {&a};
    hipError_t e = hipLaunchCooperativeKernel((const void*)fwd_megakernel, dim3(grid), dim3(512), args, LDS_BYTES, stream);
    if (e != hipSuccess) fprintf(stderr, "kernel_launch: cooperative launch failed: %s (grid %d)\n", hipGetErrorString(e), grid);
#endif
}
```

```cpp
#include <hip/hip_runtime.h>
#include <hip/hip_cooperative_groups.h>
#include <cstdio>
#include <cstdint>
namespace cg = cooperative_groups;

#define LAS __attribute__((address_space(3)))
typedef unsigned short bf16_t;
typedef short bf16x8 __attribute__((ext_vector_type(8)));
typedef short s16x4 __attribute__((ext_vector_type(4)));
typedef float f32x4 __attribute__((ext_vector_type(4)));
typedef float f32x2 __attribute__((ext_vector_type(2)));
typedef float f32x16 __attribute__((ext_vector_type(16)));
typedef unsigned u32x4 __attribute__((ext_vector_type(4)));
typedef unsigned u32x2 __attribute__((ext_vector_type(2)));
typedef __bf16 bf16x2_t __attribute__((ext_vector_type(2)));

constexpr int D = 1024, NB = 4, SEQ = 8192, CTX = 256, MLAT = NB * SEQ, MCTX = NB * CTX, MALL = MLAT + MCTX;
constexpr int NMOD = 6, QKVW = 3072, FF = 4096, SGUW = 4096, SGUH = 2048;
constexpr float EPS = 1e-6f;
constexpr float QSCALE = 0.125f * 1.4426950408889634f;

constexpr size_t MiB = 1u << 20;
constexpr size_t WS_MOD = 1 * MiB;
constexpr size_t WS_ROPE = 1 * MiB + 512 * 1024;
constexpr size_t WS_WS = 2 * MiB;
constexpr size_t WS_LNST = 2 * MiB + 512 * 1024;
constexpr size_t WS_WQKV = 3 * MiB;
constexpr size_t WS_WO = 15 * MiB;
constexpr size_t WS_WIN = 19 * MiB;
constexpr size_t WS_WOUT = 35 * MiB;
constexpr size_t WS_W1 = 43 * MiB;
constexpr size_t WS_W2 = 75 * MiB;
constexpr size_t WS_XCTX = 107 * MiB;
constexpr size_t WS_A = 111 * MiB;
constexpr size_t WS_Y = 177 * MiB;
constexpr size_t WS_BIG = 243 * MiB;
constexpr size_t WS_END = 507 * MiB;

__device__ __forceinline__ unsigned cvt_pk_bf16(float lo, float hi) { f32x2 v = {lo, hi}; bf16x2_t b = __builtin_convertvector(v, bf16x2_t); return __builtin_bit_cast(unsigned, b); }
__device__ __forceinline__ float bf_lo(unsigned u) { return __uint_as_float(u << 16); }
__device__ __forceinline__ float bf_hi(unsigned u) { return __uint_as_float(u & 0xffff0000u); }
__device__ __forceinline__ float wave_sum(float v) {
#pragma unroll
    for (int o = 1; o < 64; o <<= 1) v += __shfl_xor(v, o);
    return v;
}

__device__ __forceinline__ int launder_s(int v) { asm volatile("" : "+s"(v)); return v; }
namespace pg8 {
constexpr int BM = 256, BK = 64, HALF = 128, HTB = HALF * BK * 2, STAGE_BYTES = 8 * HTB, NXCD = 8, WGM = 8;
__host__ __device__ __forceinline__ int lds_byte(int r, int c) { const int st = (r >> 4) * 2 + (c >> 5), rr = r & 15, cc = c & 31, ob = rr * 64 + cc * 2; return st * 1024 + (ob ^ (((ob >> 9) & 1) << 5)); }
__host__ __device__ __forceinline__ void stage_rc(int b, int& R, int& C) { const int st = b / 1024, sb = b % 1024, swz = sb ^ (((sb >> 9) & 1) << 5); R = (st >> 1) * 16 + swz / 64; C = (st & 1) * 32 + (swz % 64) / 2; }
__host__ __device__ __forceinline__ int perm32(int rho) { const int n = rho >> 4, i = rho & 15; return 8 * (i >> 2) + 4 * n + (i & 3); }

struct Unit { int pm, pn; };
struct Gemm { const bf16_t* A; const bf16_t* Bt; int M, N, K, lda; };

struct StaticOrder {
    int nM, nN, nwg, G, c;
    __device__ void init(int M, int N, int G_, int c_) { nM = M / BM; nN = N / BM; nwg = nM * nN; G = G_; c = c_; }
    __device__ bool next(int i, Unit& u) const {
        const long L = (long)i * G + c; if (L >= nwg) return false;
        int wgid = (int)L; { const int q = nwg / NXCD, r = nwg % NXCD, xcd = wgid % NXCD, off = wgid / NXCD; wgid = (xcd < r ? xcd * (q + 1) : r * (q + 1) + (xcd - r) * q) + off; }
        const int nig = WGM * nN, gid = wgid / nig, fm = gid * WGM, gsz = (nM - fm) < WGM ? (nM - fm) : WGM;
        u.pm = fm + ((wgid % nig) % gsz); u.pn = (wgid % nig) / gsz; return true;
    }
};

__device__ __forceinline__ f32x2 gelu_pk(f32x2 v) {
    const f32x2 av = __builtin_elementwise_abs(v), d = av * 0.2316418882f + 1.0f;
    f32x2 t; t.x = __builtin_amdgcn_rcpf(d.x); t.y = __builtin_amdgcn_rcpf(d.y);
    f32x2 q = t * 0.5307027145f + (-0.7265760135f); q = q * t + 0.7107068705f; q = q * t + (-0.142248368f); q = q * t + 0.127414796f; q = q * t;
    const f32x2 s = (v * v) * (-0.72134752044f);
    f32x2 e; e.x = __builtin_amdgcn_exp2f(s.x); e.y = __builtin_amdgcn_exp2f(s.y);
    const f32x2 m = v * (q * e), r = v - m;
    f32x2 o; o.x = v.x < 0.f ? m.x : r.x; o.y = v.y < 0.f ? m.y : r.y; return o;
}

template <int ACT  > struct EpiBf16 {
    static constexpr bool PERM = true;
    bf16_t* O; int ldc; const float* bias;
    __device__ __forceinline__ void operator()(const f32x4 (&acc)[2][2][4][2], const Unit& u, int wr, int wc, int fr, int fq) const {
        const int row0 = u.pm * BM + wr * 64 + fr; const int col0 = u.pn * BM + wc * 32 + 8 * fq;
        f32x4 bv[2][2];
#pragma unroll
        for (int bj = 0; bj < 2; ++bj)
#pragma unroll
            for (int n = 0; n < 2; ++n) bv[bj][n] = bias ? *(const f32x4*)(bias + col0 + bj * HALF + 4 * n) : (f32x4){0.f, 0.f, 0.f, 0.f};
#pragma unroll
        for (int ai = 0; ai < 2; ++ai)
#pragma unroll
            for (int m = 0; m < 4; ++m) { bf16_t* rowp = O + (size_t)(row0 + ai * HALF + m * 16) * ldc + col0;
#pragma unroll
                for (int bj = 0; bj < 2; ++bj) { f32x4 v0 = acc[ai][bj][m][0] + bv[bj][0], v1 = acc[ai][bj][m][1] + bv[bj][1];
                    if (ACT == 1) { f32x2 a = gelu_pk((f32x2){v0[0], v0[1]}), b = gelu_pk((f32x2){v0[2], v0[3]}), c = gelu_pk((f32x2){v1[0], v1[1]}), d = gelu_pk((f32x2){v1[2], v1[3]});
                        v0 = (f32x4){a.x, a.y, b.x, b.y}; v1 = (f32x4){c.x, c.y, d.x, d.y}; }
                    if (ACT == 2) {
#pragma unroll
                        for (int e = 0; e < 4; ++e) { const float a = fmaxf(v0[e], 0.f), b = fmaxf(v1[e], 0.f); v0[e] = a * a; v1[e] = b * b; } }
                    u32x4 w; w.x = cvt_pk_bf16(v0[0], v0[1]); w.y = cvt_pk_bf16(v0[2], v0[3]); w.z = cvt_pk_bf16(v1[0], v1[1]); w.w = cvt_pk_bf16(v1[2], v1[3]);
                    *(u32x4*)(rowp + bj * HALF) = w; } }
    }
};
struct EpiQKV {
    static constexpr bool PERM = true;
    bf16_t* O; const float* rope;
    __device__ __forceinline__ void operator()(const f32x4 (&acc)[2][2][4][2], const Unit& u, int wr, int wc, int fr, int fq) const {
        const int row0 = u.pm * BM + wr * 64 + fr; const int col0 = u.pn * BM + wc * 32 + 8 * fq;
        const bool do_rope = (u.pn < 8) && (u.pm < MLAT / BM);
        const float sc = (u.pn < 4) ? QSCALE : 1.f;
#pragma unroll
        for (int ai = 0; ai < 2; ++ai)
#pragma unroll
            for (int m = 0; m < 4; ++m) { const int row = row0 + ai * HALF + m * 16; bf16_t* rowp = O + (size_t)row * QKVW + col0;
                f32x4 cs0 = {1.f, 0.f, 1.f, 0.f}, cs1 = {1.f, 0.f, 1.f, 0.f};
                if (do_rope) { const int s = row & (SEQ - 1); const int pos = (wc & 1) ? (s & 63) : (s >> 6); const float* t = rope + (pos * 16 + 4 * fq) * 2; cs0 = *(const f32x4*)t; cs1 = *(const f32x4*)(t + 4); }
#pragma unroll
                for (int bj = 0; bj < 2; ++bj) { const f32x4 v0 = acc[ai][bj][m][0], v1 = acc[ai][bj][m][1]; f32x4 o0, o1;
                    o0[0] = v0[0] * cs0[0] - v0[1] * cs0[1]; o0[1] = v0[1] * cs0[0] + v0[0] * cs0[1];
                    o0[2] = v0[2] * cs0[2] - v0[3] * cs0[3]; o0[3] = v0[3] * cs0[2] + v0[2] * cs0[3];
                    o1[0] = v1[0] * cs1[0] - v1[1] * cs1[1]; o1[1] = v1[1] * cs1[0] + v1[0] * cs1[1];
                    o1[2] = v1[2] * cs1[2] - v1[3] * cs1[3]; o1[3] = v1[3] * cs1[2] + v1[2] * cs1[3];
                    o0 = o0 * sc; o1 = o1 * sc;
                    u32x4 w; w.x = cvt_pk_bf16(o0[0], o0[1]); w.y = cvt_pk_bf16(o0[2], o0[3]); w.z = cvt_pk_bf16(o1[0], o1[1]); w.w = cvt_pk_bf16(o1[2], o1[3]);
                    *(u32x4*)(rowp + bj * HALF) = w; } }
    }
};

template <class Epi, bool ALIGN_EPI = true>
__device__ __forceinline__ void gemm_phase(LAS unsigned char* lds, const Gemm g, const StaticOrder& S, const Epi& E) {
    int tid_ = threadIdx.x; asm volatile("" : "+v"(tid_)); const int tid = tid_, wid = __builtin_amdgcn_readfirstlane(tid >> 6), lane = tid & 63, wr = wid >> 2, wc = wid & 3, fr = lane & 15, fq = lane >> 4;
    const int K = g.K, nt = K / BK, lda = g.lda;
    unsigned voffA[2], voffB[2];
#pragma unroll
    for (int i = 0; i < 2; ++i) { int R, C; stage_rc(tid * 16 + i * 8192, R, C); const int Rb = Epi::PERM ? ((R & ~31) + perm32(R & 31)) : R;
        voffA[i] = (unsigned)(R * lda + C) * 2u; voffB[i] = (unsigned)(Rb * K + C) * 2u; }
    const size_t kstep = (size_t)(BK * 2);
    const size_t hstepA = (size_t)HALF * lda * 2, hstepB = (size_t)HALF * K * 2;
    const size_t tstepA = 2 * hstepA, tstepB = 2 * hstepB;
    const unsigned ldsw = (unsigned)wid * 1024u;
    const int aoff = lds_byte(wr * 64 + fr, fq * 8), boff = lds_byte(wc * 32 + fr, fq * 8);
#define PG8_SA(b, h) (((b) * 2 + (h)) * HTB)
#define PG8_SB(b, h) ((4 + (b) * 2 + (h)) * HTB)
#define PG8_STAGE(bufoff, gbase, voff) do { _Pragma("unroll") for (int _i = 0; _i < 2; ++_i) \
        __builtin_amdgcn_global_load_lds((const unsigned*)((const char*)(gbase) + (voff)[_i]), (LAS unsigned*)(lds + (bufoff) + ldsw + _i * 8192), 16, 0, 0); } while (0)
#define PG8_LDA(dst, b, h) do { _Pragma("unroll") for (int m = 0; m < 4; ++m) _Pragma("unroll") for (int k = 0; k < 2; ++k) dst[m][k] = *(const LAS bf16x8*)(lds + PG8_SA(b, h) + aoff + m * 2048 + k * 1024); } while (0)
#define PG8_LDB(dst, b, h) do { _Pragma("unroll") for (int n = 0; n < 2; ++n) _Pragma("unroll") for (int k = 0; k < 2; ++k) dst[n][k] = *(const LAS bf16x8*)(lds + PG8_SB(b, h) + boff + n * 2048 + k * 1024); } while (0)
#define PG8_MMA(ai, bj, At, Bt) do { __builtin_amdgcn_s_setprio(1); _Pragma("unroll") for (int m = 0; m < 4; ++m) _Pragma("unroll") for (int n = 0; n < 2; ++n) _Pragma("unroll") for (int k = 0; k < 2; ++k) \
        acc[ai][bj][m][n] = __builtin_amdgcn_mfma_f32_16x16x32_bf16(Bt[n][k], At[m][k], acc[ai][bj][m][n], 0, 0, 0); __builtin_amdgcn_s_setprio(0); } while (0)
#define PG8_WAIT_V(n) asm volatile("s_waitcnt vmcnt(" #n ")" ::: "memory")
#define PG8_WAIT_L(n) asm volatile("s_waitcnt lgkmcnt(" #n ")" ::: "memory")
#define PG8_BAR __builtin_amdgcn_s_barrier()
#define PG8_SCHED __builtin_amdgcn_sched_barrier(0)
    Unit cur, nxt; int ui = 0;
    if (!S.next(0, cur)) return;
    f32x4 acc[2][2][4][2];
#pragma unroll
    for (int a = 0; a < 2; ++a)
#pragma unroll
        for (int b = 0; b < 2; ++b)
#pragma unroll
            for (int m = 0; m < 4; ++m)
#pragma unroll
                for (int n = 0; n < 2; ++n) acc[a][b][m][n] = (f32x4){0.f, 0.f, 0.f, 0.f};
    bf16x8 At[4][2], B0[2][2], B1[2][2];
    const char* cA = (const char*)g.A + (size_t)cur.pm * tstepA; const char* cB = (const char*)g.Bt + (size_t)cur.pn * tstepB;
    PG8_STAGE(PG8_SB(0, 0), cB, voffB); PG8_STAGE(PG8_SB(0, 1), cB + hstepB, voffB); PG8_STAGE(PG8_SA(0, 0), cA, voffA); PG8_STAGE(PG8_SA(0, 1), cA + hstepA, voffA);
    if (wr == 1) PG8_BAR;
    PG8_WAIT_V(2); PG8_BAR;
    PG8_STAGE(PG8_SB(1, 0), cB + kstep, voffB); PG8_STAGE(PG8_SA(1, 0), cA + kstep, voffA); PG8_STAGE(PG8_SB(1, 1), cB + hstepB + kstep, voffB);
    PG8_WAIT_V(6); PG8_BAR;
    for (;;) {
        const bool has_next = S.next(ui + 1, nxt);
        const char* nA = has_next ? (const char*)g.A + (size_t)nxt.pm * tstepA : cA; const char* nB = has_next ? (const char*)g.Bt + (size_t)nxt.pn * tstepB : cB;
        for (int t = 0; t < nt; t += 2) {
            const bool last = (t == nt - 2);
            const char* a1 = cA + (size_t)(t + 1) * kstep;
            const char* a2 = last ? nA : cA + (size_t)(t + 2) * kstep; const char* b2 = last ? nB : cB + (size_t)(t + 2) * kstep;
            const char* a3 = a2 + kstep; const char* b3 = b2 + kstep;
            PG8_LDB(B0, 0, 0); PG8_LDB(B1, 0, 1); PG8_SCHED; PG8_LDA(At, 0, 0); PG8_STAGE(PG8_SA(1, 1), a1 + hstepA, voffA);
            PG8_WAIT_V(8); PG8_WAIT_L(0); PG8_BAR; PG8_MMA(0, 0, At, B0); PG8_MMA(0, 1, At, B1); PG8_BAR; PG8_SCHED;
            PG8_LDA(At, 0, 1); PG8_STAGE(PG8_SB(0, 0), b2, voffB); PG8_STAGE(PG8_SB(0, 1), b2 + hstepB, voffB); PG8_STAGE(PG8_SA(0, 0), a2, voffA);
            PG8_WAIT_V(8); PG8_WAIT_L(0); PG8_BAR; PG8_MMA(1, 0, At, B0); PG8_MMA(1, 1, At, B1); PG8_BAR; PG8_SCHED;
            PG8_LDB(B0, 1, 0); PG8_LDB(B1, 1, 1); PG8_SCHED; PG8_LDA(At, 1, 0); PG8_STAGE(PG8_SA(0, 1), a2 + hstepA, voffA);
            PG8_WAIT_V(8); PG8_WAIT_L(0); PG8_BAR; PG8_MMA(0, 0, At, B0); PG8_MMA(0, 1, At, B1); PG8_BAR; PG8_SCHED;
            PG8_LDA(At, 1, 1); PG8_STAGE(PG8_SB(1, 0), b3, voffB); PG8_STAGE(PG8_SB(1, 1), b3 + hstepB, voffB); PG8_STAGE(PG8_SA(1, 0), a3, voffA);
            PG8_WAIT_V(8); PG8_WAIT_L(0); PG8_BAR; PG8_MMA(1, 0, At, B0); PG8_MMA(1, 1, At, B1); PG8_BAR; PG8_SCHED;
        }
        if constexpr (ALIGN_EPI) { if (wr == 0) PG8_BAR; }
        E(acc, cur, wr, wc, fr, fq);
        if (!has_next) break;
#pragma unroll
        for (int a = 0; a < 2; ++a)
#pragma unroll
            for (int b = 0; b < 2; ++b)
#pragma unroll
                for (int m = 0; m < 4; ++m)
#pragma unroll
                    for (int n = 0; n < 2; ++n) acc[a][b][m][n] = (f32x4){0.f, 0.f, 0.f, 0.f};
        cur = nxt; cA = nA; cB = nB; ++ui;
        if constexpr (ALIGN_EPI) { if (wr == 1) PG8_BAR; }
    }
    PG8_WAIT_V(0);
    if constexpr (!ALIGN_EPI) { if (wr == 0) PG8_BAR; }
    PG8_BAR;
#undef PG8_SA
#undef PG8_SB
#undef PG8_STAGE
#undef PG8_LDA
#undef PG8_LDB
#undef PG8_MMA
#undef PG8_WAIT_V
#undef PG8_WAIT_L
#undef PG8_BAR
#undef PG8_SCHED
}
}

struct Args {
    const float* in[20];
    float* out; unsigned char* ws;
    int ph_lo, ph_hi;
};
enum { I_X = 0, I_C, I_CTX, I_CCTX, I_WMOD, I_BMOD, I_NORMG, I_WQKV, I_WO, I_LAMBDA, I_SUBLN, I_SWIN, I_SBIN, I_SLNG, I_SLNB, I_SWS, I_SBS, I_SWOUT, I_W1, I_W2 };

__device__ __forceinline__ void transpose_item(const float* W, int K, int N, bf16_t* WT, LAS float* scr, int item, int lane, int perm_cols) {
    const int nblk = N / 32, kb = item / nblk, nb = item % nblk, k0 = 64 * kb, n0 = 32 * nb;
#pragma unroll 8
    for (int i = 0; i < 32; ++i) { const int kk = 2 * i + (lane >> 5); scr[kk * 33 + (lane & 31)] = W[(size_t)(k0 + kk) * N + n0 + (lane & 31)]; }
    asm volatile("s_waitcnt lgkmcnt(0)" ::: "memory");
    const int c = lane & 7; const bool perm = n0 < perm_cols;
#pragma unroll
    for (int j = 0; j < 4; ++j) { const int n = (lane >> 3) + 8 * j; const int sn = perm ? ((n >> 1) + 16 * (n & 1)) : n; const LAS float* s = scr + (8 * c) * 33 + sn;
        u32x4 o; o.x = cvt_pk_bf16(s[0 * 33], s[1 * 33]); o.y = cvt_pk_bf16(s[2 * 33], s[3 * 33]); o.z = cvt_pk_bf16(s[4 * 33], s[5 * 33]); o.w = cvt_pk_bf16(s[6 * 33], s[7 * 33]);
        *(u32x4*)(WT + (size_t)(n0 + n) * K + k0 + 8 * c) = o; }
    asm volatile("s_waitcnt lgkmcnt(0)" ::: "memory");
}

__device__ __forceinline__ float silu_f(float v) { return v / (1.f + __expf(-v)); }

__device__ __forceinline__ void phase_prologue(const Args& a, LAS unsigned char* lds) {
    int tid_ = threadIdx.x; asm volatile("" : "+v"(tid_)); const int tid = tid_, lane = tid & 63, wave = tid >> 6, G = launder_s(gridDim.x), bx = launder_s(blockIdx.x);
    unsigned char* ws = a.ws;
    {
        LAS float* sl = (LAS float*)lds;
        LAS float* red = (LAS float*)(lds + 20480);
        if (bx < 192) {
            for (int i = tid; i < 5 * 1024; i += 512) { const int bb = i >> 10, k = i & 1023; const float v = (bb < 4) ? a.in[I_C][bb * 1024 + k] : a.in[I_CCTX][k]; sl[i] = silu_f(v); }
            __syncthreads();
            float* mod = (float*)(ws + WS_MOD);
            for (int it = bx; it < 192; it += G) {
                const int l = it / 48, cg_ = it % 48, col0 = cg_ * 128 + 2 * lane;
                const float* wp = a.in[I_WMOD] + ((size_t)l * 1024 + wave * 128) * 6144 + col0;
                float acc[5][2];
#pragma unroll
                for (int bb = 0; bb < 5; ++bb) { acc[bb][0] = 0.f; acc[bb][1] = 0.f; }
#pragma unroll 8
                for (int k = 0; k < 128; ++k) { const f32x2 w = *(const f32x2*)(wp + (size_t)k * 6144);
#pragma unroll
                    for (int bb = 0; bb < 5; ++bb) { const float s = sl[bb * 1024 + wave * 128 + k]; acc[bb][0] += s * w.x; acc[bb][1] += s * w.y; } }
#pragma unroll
                for (int bb = 0; bb < 5; ++bb) { red[(wave * 5 + bb) * 128 + 2 * lane] = acc[bb][0]; red[(wave * 5 + bb) * 128 + 2 * lane + 1] = acc[bb][1]; }
                __syncthreads();
                for (int o = tid; o < 640; o += 512) { const int bb = o >> 7, cc = o & 127; float s = 0.f;
#pragma unroll
                    for (int w = 0; w < 8; ++w) s += red[(w * 5 + bb) * 128 + cc];
                    const int n = cg_ * 128 + cc; mod[((size_t)l * 5 + bb) * 6144 + n] = s + a.in[I_BMOD][l * 6144 + n]; }
                __syncthreads();
            }
        }
        __syncthreads();
    }
    const int gt = bx * 512 + tid, NT = G * 512;
    { float* rope = (float*)(ws + WS_ROPE);
      for (int i = gt; i < 128 * 16; i += NT) { const int pos = i >> 4, p = i & 15; const float inv = powf(10000.f, -(float)p / 16.f); const float ang = (float)pos * inv; rope[2 * i] = cosf(ang); rope[2 * i + 1] = sinf(ang); }
      bf16_t* wsb = (bf16_t*)(ws + WS_WS); const float* src = a.in[I_SWS];
      for (int i = gt; i < 2 * 8 * 128 * 128 / 4; i += NT) { const f32x4 v = *(const f32x4*)(src + 4 * (size_t)i); u32x2 o; o.x = cvt_pk_bf16(v[0], v[1]); o.y = cvt_pk_bf16(v[2], v[3]); *(u32x2*)(wsb + 4 * (size_t)i) = o; } }
    {
        LAS float* scr = (LAS float*)(lds + wave * 8448);
        const int vcu = (G % 8 == 0) ? (bx % 8) * (G / 8) + bx / 8 : bx;
        const int gw = vcu * 8 + wave, NGW = G * 8;
        constexpr int I_Q = 16 * 96, I_O = 16 * 32, I_IN = 16 * 128, I_OUT = 32 * 32, I_1 = 16 * 128, I_2 = 64 * 32;
        constexpr int NITEMS = 2 * I_Q + 2 * I_O + 2 * I_IN + 2 * I_OUT + 4 * I_1 + 4 * I_2;
        for (int it = gw; it < NITEMS; it += NGW) {
            int r = it;
            if (r < 2 * I_Q) { const int j = r / I_Q; transpose_item(a.in[I_WQKV] + (size_t)j * 1024 * 3072, 1024, 3072, (bf16_t*)(ws + WS_WQKV) + (size_t)j * 3072 * 1024, scr, r % I_Q, lane, 2048); continue; } r -= 2 * I_Q;
            if (r < 2 * I_O) { const int j = r / I_O; transpose_item(a.in[I_WO] + (size_t)j * 1024 * 1024, 1024, 1024, (bf16_t*)(ws + WS_WO) + (size_t)j * 1024 * 1024, scr, r % I_O, lane, 0); continue; } r -= 2 * I_O;
            if (r < 2 * I_IN) { const int j = r / I_IN; transpose_item(a.in[I_SWIN] + (size_t)j * 1024 * 4096, 1024, 4096, (bf16_t*)(ws + WS_WIN) + (size_t)j * 4096 * 1024, scr, r % I_IN, lane, 0); continue; } r -= 2 * I_IN;
            if (r < 2 * I_OUT) { const int j = r / I_OUT; transpose_item(a.in[I_SWOUT] + (size_t)j * 2048 * 1024, 2048, 1024, (bf16_t*)(ws + WS_WOUT) + (size_t)j * 1024 * 2048, scr, r % I_OUT, lane, 0); continue; } r -= 2 * I_OUT;
            if (r < 4 * I_1) { const int j = r / I_1; transpose_item(a.in[I_W1] + (size_t)j * 1024 * 4096, 1024, 4096, (bf16_t*)(ws + WS_W1) + (size_t)j * 4096 * 1024, scr, r % I_1, lane, 0); continue; } r -= 4 * I_1;
            { const int j = r / I_2; transpose_item(a.in[I_W2] + (size_t)j * 4096 * 1024, 4096, 1024, (bf16_t*)(ws + WS_W2) + (size_t)j * 1024 * 4096, scr, r % I_2, lane, 0); }
        }
    }
}

struct RowPass {
    const float* xin_lat; const float* xin_ctx; float* xout_lat;
    const bf16_t* xin_bf; bf16_t* xout_bf;
    const bf16_t* Y; const float* g_post; const float* gate;
    bf16_t* A; const float* g_pre; const float* shift; const float* scale;
    int nrows;
};
constexpr int RP_R = 4;
__device__ __forceinline__ void phase_rowpass(const RowPass& p) {
    int tid_ = threadIdx.x; asm volatile("" : "+v"(tid_)); const int tid = tid_, lane = tid & 63, wave = tid >> 6, G = launder_s(gridDim.x);
    const int gw = launder_s(blockIdx.x) * 8 + wave, NGW = G * 8;
    for (int row0 = gw; row0 < p.nrows; row0 += RP_R * NGW) {
        int rows[RP_R]; bool ok[RP_R];
#pragma unroll
        for (int u = 0; u < RP_R; ++u) { rows[u] = row0 + u * NGW; ok[u] = rows[u] < p.nrows; if (!ok[u]) rows[u] = row0; }
        f32x4 v[RP_R][4]; u32x2 yw[RP_R][4];
#pragma unroll
        for (int u = 0; u < RP_R; ++u) { const int row = rows[u]; const bool lat = row < MLAT;
            if (p.xin_bf) { const bf16_t* xb = p.xin_bf + (size_t)row * D;
#pragma unroll
                for (int j = 0; j < 4; ++j) { const u32x2 w = *(const u32x2*)(xb + 4 * lane + 256 * j); v[u][j] = (f32x4){bf_lo(w.x), bf_hi(w.x), bf_lo(w.y), bf_hi(w.y)}; } }
            else { const float* xr = lat ? p.xin_lat + (size_t)row * D : p.xin_ctx + (size_t)(row - MLAT) * D;
#pragma unroll
                for (int j = 0; j < 4; ++j) v[u][j] = *(const f32x4*)(xr + 4 * lane + 256 * j); }
            if (p.Y) { const bf16_t* yr = p.Y + (size_t)row * D;
#pragma unroll
                for (int j = 0; j < 4; ++j) yw[u][j] = *(const u32x2*)(yr + 4 * lane + 256 * j); } }
#pragma unroll
        for (int u = 0; u < RP_R; ++u) { const int row = rows[u]; const bool lat = row < MLAT; const int bb = lat ? (row >> 13) : 4;
            if (!ok[u]) continue;
            if (p.Y) {
                f32x4 y[4]; float ss = 0.f;
#pragma unroll
                for (int j = 0; j < 4; ++j) { const u32x2 w = yw[u][j]; y[j] = (f32x4){bf_lo(w.x), bf_hi(w.x), bf_lo(w.y), bf_hi(w.y)}; ss += (y[j][0] * y[j][0] + y[j][1] * y[j][1]) + (y[j][2] * y[j][2] + y[j][3] * y[j][3]); }
                const float r = rsqrtf(wave_sum(ss) * (1.f / D) + EPS);
#pragma unroll
                for (int j = 0; j < 4; ++j) { const f32x4 gp = *(const f32x4*)(p.g_post + 4 * lane + 256 * j); const f32x4 gt = *(const f32x4*)(p.gate + (size_t)bb * 6144 + 4 * lane + 256 * j); v[u][j] = v[u][j] + gt * (y[j] * r * gp); }
            }
            if (p.xout_bf) { bf16_t* xb = p.xout_bf + (size_t)row * D;
#pragma unroll
                for (int j = 0; j < 4; ++j) { u32x2 w; w.x = cvt_pk_bf16(v[u][j][0], v[u][j][1]); w.y = cvt_pk_bf16(v[u][j][2], v[u][j][3]); *(u32x2*)(xb + 4 * lane + 256 * j) = w; } }
            if (p.xout_lat && lat) { float* xo = p.xout_lat + (size_t)row * D;
#pragma unroll
                for (int j = 0; j < 4; ++j) *(f32x4*)(xo + 4 * lane + 256 * j) = v[u][j]; }
            if (p.A) {
                float ss = 0.f;
#pragma unroll
                for (int j = 0; j < 4; ++j) ss += (v[u][j][0] * v[u][j][0] + v[u][j][1] * v[u][j][1]) + (v[u][j][2] * v[u][j][2] + v[u][j][3] * v[u][j][3]);
                const float r = rsqrtf(wave_sum(ss) * (1.f / D) + EPS);
                bf16_t* ar = p.A + (size_t)row * D;
#pragma unroll
                for (int j = 0; j < 4; ++j) { const f32x4 gp = *(const f32x4*)(p.g_pre + 4 * lane + 256 * j); const f32x4 sh = *(const f32x4*)(p.shift + (size_t)bb * 6144 + 4 * lane + 256 * j); const f32x4 sc = *(const f32x4*)(p.scale + (size_t)bb * 6144 + 4 * lane + 256 * j);
                    const f32x4 o = (v[u][j] * r * gp) * (sc + 1.f) + sh; u32x2 w; w.x = cvt_pk_bf16(o[0], o[1]); w.y = cvt_pk_bf16(o[2], o[3]); *(u32x2*)(ar + 4 * lane + 256 * j) = w; }
            }
        }
    }
}

constexpr int AT_STAGE = 32768;
__device__ __forceinline__ float swap32_max(float m) { auto rr = __builtin_amdgcn_permlane32_swap(__float_as_uint(m), __float_as_uint(m), false, false); return fmaxf(__uint_as_float(rr[0]), __uint_as_float(rr[1])); }
__device__ __forceinline__ float swap32_sum(float m) { auto rr = __builtin_amdgcn_permlane32_swap(__float_as_uint(m), __float_as_uint(m), false, false); return __uint_as_float(rr[0]) + __uint_as_float(rr[1]); }

__device__ __forceinline__ float at_sub(float a, float b) { return a - b; }
__device__ __forceinline__ float at_add(float a, float b) { return a + b; }
template <bool FAST> __device__ __forceinline__ bool attn_unit(LAS unsigned char* lds, const bf16_t* QKV, bf16_t* O, int qrow0, int b, int h, int nt, float lam, float oscale, const float* subln_g) {
    int tid_ = threadIdx.x; asm volatile("" : "+v"(tid_)); const int tid = tid_, lane = tid & 63, wid = __builtin_amdgcn_readfirstlane(tid >> 6), r32 = lane & 31, hi = lane >> 5;
    const int map = wid >> 2, wq = wid & 3;
    const int lrow = tid >> 4, lch = tid & 15;
    const unsigned gofs = (unsigned)((lrow * QKVW + 1024 + h * 128 + lch * 8) * 2);
    const unsigned koff = (unsigned)((lch >> 3) * 8192 + lrow * 128 + (((lch & 7) ^ ((lrow >> 1) & 7)) << 4));
    const unsigned voff = (unsigned)((lch >> 2) * 4096 + (lrow >> 3) * 512 + (lrow & 7) * 64 + (lch & 3) * 16);
    u32x4 kr[2], vr[2];
#define AT_SB() __builtin_amdgcn_sched_barrier(0)
#define AT_TROW(t) (((t) < 4) ? (size_t)(MLAT + b * CTX + 64 * (t)) : (size_t)(b * SEQ + 64 * ((t) - 4)))
#define AT_GLOAD_K(t) do { const char* tb_ = (const char*)(QKV + AT_TROW(t) * QKVW) + gofs; kr[0] = *(const u32x4*)(tb_); kr[1] = *(const u32x4*)(tb_ + 32 * QKVW * 2); } while (0)
#define AT_GLOAD_V(t) do { const char* tb_ = (const char*)(QKV + AT_TROW(t) * QKVW) + gofs; vr[0] = *(const u32x4*)(tb_ + 2048); vr[1] = *(const u32x4*)(tb_ + 32 * QKVW * 2 + 2048); } while (0)
#define AT_LSTORE_K(so) do { *(LAS u32x4*)(lds + (so) + koff) = kr[0]; *(LAS u32x4*)(lds + (so) + koff + 4096) = kr[1]; } while (0)
#define AT_LSTORE_V(so) do { *(LAS u32x4*)(lds + (so) + voff) = vr[0]; *(LAS u32x4*)(lds + (so) + voff + 2048) = vr[1]; } while (0)
#define AT_MF(a, b, c) __builtin_amdgcn_mfma_f32_32x32x16_bf16((a), (b), (c), 0, 0, 0)
#define AT_KRD(s_) do { const int co_ = ((2 * (s_) + hi) ^ ksw) << 4; k0_[(s_) & 1] = *(const LAS bf16x8*)(kb_ + co_); k1_[(s_) & 1] = *(const LAS bf16x8*)(kb_ + 4096 + co_); } while (0)
#define AT_S(P0, P1, kso) do { LAS const unsigned char* kb_ = lds + (kso) + kbase; bf16x8 k0_[2], k1_[2]; const f32x16 z_ = {0.f,0.f,0.f,0.f,0.f,0.f,0.f,0.f,0.f,0.f,0.f,0.f,0.f,0.f,0.f,0.f}; \
        AT_KRD(0); AT_KRD(1); \
        P0 = AT_MF(k0_[0], qf[0], z_); P1 = AT_MF(k1_[0], qf[0], z_); AT_KRD(2); \
        P0 = AT_MF(k0_[1], qf[1], P0); P1 = AT_MF(k1_[1], qf[1], P1); AT_KRD(3); \
        P0 = AT_MF(k0_[0], qf[2], P0); P1 = AT_MF(k1_[0], qf[2], P1); \
        P0 = AT_MF(k0_[1], qf[3], P0); P1 = AT_MF(k1_[1], qf[3], P1); } while (0)
#define AT_ROWMAX(P0, P1, out) do { float ta_ = fmaxf(fmaxf(P0[0], P0[1]), P1[0]), tb_ = fmaxf(fmaxf(P0[2], P0[3]), P1[1]); ta_ = fmaxf(fmaxf(ta_, P1[2]), P1[3]); \
        _Pragma("unroll") for (int i_ = 4; i_ < 16; i_ += 4) { ta_ = fmaxf(fmaxf(ta_, P0[i_]), P0[i_ + 1]); tb_ = fmaxf(fmaxf(tb_, P0[i_ + 2]), P0[i_ + 3]); ta_ = fmaxf(fmaxf(ta_, P1[i_]), P1[i_ + 1]); tb_ = fmaxf(fmaxf(tb_, P1[i_ + 2]), P1[i_ + 3]); } \
        out = swap32_max(fmaxf(ta_, tb_)); } while (0)
#define AT_VRD(dst, c, kp) do { _Pragma("unroll") for (int k2_ = 0; k2_ < 2; ++k2_) { const int ks_ = 2 * (kp) + k2_; \
        const s16x4 lo_ = __builtin_bit_cast(s16x4, __builtin_amdgcn_ds_read_tr16_b64_v4i16((LAS s16x4*)(vb_ + (c) * 4096 + ks_ * 1024))); \
        const s16x4 hh_ = __builtin_bit_cast(s16x4, __builtin_amdgcn_ds_read_tr16_b64_v4i16((LAS s16x4*)(vb_ + (c) * 4096 + ks_ * 1024 + 512))); \
        dst[k2_] = __builtin_shufflevector(lo_, hh_, 0, 1, 2, 3, 4, 5, 6, 7); } } while (0)
#define AT_PVC(src, c, kp) do { _Pragma("unroll") for (int k2_ = 0; k2_ < 2; ++k2_) o[c] = AT_MF(src[k2_], pf[2 * (kp) + k2_], o[c]); } while (0)
#define AT_PVALL(vso, first_done) do { LAS const unsigned char* vb_ = lds + (vso) + vbase; \
        if (!(first_done)) { AT_VRD(va_, 0, 0); } \
        AT_SB(); AT_VRD(vc_, 0, 1); AT_SB(); AT_PVC(va_, 0, 0); AT_SB(); \
        AT_VRD(va_, 1, 0); AT_SB(); AT_PVC(vc_, 0, 1); AT_SB(); \
        AT_VRD(vc_, 1, 1); AT_SB(); AT_PVC(va_, 1, 0); AT_SB(); \
        AT_VRD(va_, 2, 0); AT_SB(); AT_PVC(vc_, 1, 1); AT_SB(); \
        AT_VRD(vc_, 2, 1); AT_SB(); AT_PVC(va_, 2, 0); AT_SB(); \
        AT_VRD(va_, 3, 0); AT_SB(); AT_PVC(vc_, 2, 1); AT_SB(); \
        AT_VRD(vc_, 3, 1); AT_SB(); AT_PVC(va_, 3, 0); AT_SB(); \
        AT_PVC(vc_, 3, 1); AT_SB(); } while (0)
#define AT_STEP(t, C0, C1, N0, N1, kso_next, kso_store) do { \
        const bool more1_ = (t) + 1 < nt, more2_ = (t) + 2 < nt; bf16x8 va_[2], vc_[2]; \
        if (more2_) AT_GLOAD_K((t) + 2); if (more1_) AT_GLOAD_V((t) + 1); \
        if (map == 1 && (t) > 0) AT_PVALL(vs_prev, false); \
        if (more1_) AT_S(N0, N1, kso_next); \
        if constexpr (!FAST) { float tm_; AT_ROWMAX(C0, C1, tm_); \
        if (__any(tm_ > mrun + 8.0f)) { const float mn_ = fmaxf(tm_, mrun); const float al_ = __builtin_amdgcn_exp2f(mrun - mn_); mrun = mn_; lrun *= al_; \
            _Pragma("unroll") for (int c_ = 0; c_ < 4; ++c_) _Pragma("unroll") for (int i_ = 0; i_ < 16; ++i_) o[c_][i_] *= al_; } } \
        if (map == 0) { LAS const unsigned char* vb_ = lds + vs_cur + vbase; AT_VRD(va_, 0, 0); } AT_SB(); \
        float sacc_ = 0.f; \
        _Pragma("unroll") for (int i_ = 0; i_ < 16; i_ += 2) { C0[i_] = __builtin_amdgcn_exp2f(FAST ? C0[i_] : at_sub(C0[i_], mrun)); C0[i_ + 1] = __builtin_amdgcn_exp2f(FAST ? C0[i_ + 1] : at_sub(C0[i_ + 1], mrun)); C1[i_] = __builtin_amdgcn_exp2f(FAST ? C1[i_] : at_sub(C1[i_], mrun)); C1[i_ + 1] = __builtin_amdgcn_exp2f(FAST ? C1[i_ + 1] : at_sub(C1[i_ + 1], mrun)); \
            sacc_ += C0[i_]; sacc_ += C0[i_ + 1]; sacc_ += C1[i_]; sacc_ += C1[i_ + 1]; asm volatile("" : "+v"(sacc_)); } \
        lrun += sacc_; \
        { u32x4 w_; \
          w_.x = cvt_pk_bf16(C0[0], C0[1]); w_.y = cvt_pk_bf16(C0[2], C0[3]); w_.z = cvt_pk_bf16(C0[4], C0[5]); w_.w = cvt_pk_bf16(C0[6], C0[7]); pf[0] = __builtin_bit_cast(bf16x8, w_); \
          w_.x = cvt_pk_bf16(C0[8], C0[9]); w_.y = cvt_pk_bf16(C0[10], C0[11]); w_.z = cvt_pk_bf16(C0[12], C0[13]); w_.w = cvt_pk_bf16(C0[14], C0[15]); pf[1] = __builtin_bit_cast(bf16x8, w_); \
          w_.x = cvt_pk_bf16(C1[0], C1[1]); w_.y = cvt_pk_bf16(C1[2], C1[3]); w_.z = cvt_pk_bf16(C1[4], C1[5]); w_.w = cvt_pk_bf16(C1[6], C1[7]); pf[2] = __builtin_bit_cast(bf16x8, w_); \
          w_.x = cvt_pk_bf16(C1[8], C1[9]); w_.y = cvt_pk_bf16(C1[10], C1[11]); w_.z = cvt_pk_bf16(C1[12], C1[13]); w_.w = cvt_pk_bf16(C1[14], C1[15]); pf[3] = __builtin_bit_cast(bf16x8, w_); } \
        if (map == 0) AT_PVALL(vs_cur, true); \
        if (more2_) AT_LSTORE_K(kso_store); if (more1_) AT_LSTORE_V(vs_next); \
        __syncthreads(); \
        vs_prev = vs_cur; vs_cur = vs_next; vs_next = (vs_next == 32768 + 2 * 16384) ? 32768 : vs_next + 16384; } while (0)

    const int kbase = map * 8192 + r32 * 128; const int ksw = (r32 >> 1) & 7;
    const int vbase = ((lane >> 4) & 1) * 32 + (lane & 3) * 8 + (4 * hi + ((lane & 15) >> 2)) * 64;
    AT_GLOAD_K(0); AT_GLOAD_V(0);
    bf16x8 qf[4];
    { const bf16_t* qp = QKV + (size_t)(qrow0 + wq * 32 + r32) * QKVW + h * 128 + map * 64 + hi * 8;
#pragma unroll
      for (int s = 0; s < 4; ++s) qf[s] = *(const bf16x8*)(qp + 16 * s); }
    AT_LSTORE_K(0); AT_LSTORE_V(32768);
    AT_GLOAD_K(1); AT_LSTORE_K(16384);
    __syncthreads();
    f32x16 o[4], pA0, pA1, pB0, pB1;
#pragma unroll
    for (int c = 0; c < 4; ++c)
#pragma unroll
        for (int i = 0; i < 16; ++i) o[c][i] = 0.f;
#pragma unroll
    for (int i = 0; i < 16; ++i) { pB0[i] = 0.f; pB1[i] = 0.f; }
    bf16x8 pf[4];
    float mrun, lrun = 0.f;
    int vs_prev = 32768 + 2 * 16384, vs_cur = 32768, vs_next = 32768 + 16384;
    AT_S(pA0, pA1, 0);
    if constexpr (FAST) mrun = 0.f; else { float tm0; AT_ROWMAX(pA0, pA1, tm0); mrun = tm0; }
    asm volatile("s_nop 7\n\ts_nop 7" ::: "memory");
    __syncthreads();
    for (int it = 0; it < nt; it += 2) {
        AT_STEP(it,     pA0, pA1, pB0, pB1, 16384, 0);
        AT_STEP(it + 1, pB0, pB1, pA0, pA1, 0,     16384);
    }
    if (map == 1) { bf16x8 va_[2], vc_[2]; AT_PVALL(vs_prev, false); }
    __syncthreads();
#undef AT_SB
#undef AT_TROW
#undef AT_GLOAD_K
#undef AT_GLOAD_V
#undef AT_LSTORE_K
#undef AT_LSTORE_V
#undef AT_MF
#undef AT_S
#undef AT_KRD
#undef AT_ROWMAX
#undef AT_VRD
#undef AT_PVC
#undef AT_PVALL
#undef AT_STEP
    const float ltot = swap32_sum(lrun);
    if constexpr (FAST) {
        const int bad = !((ltot > 1.0e-30f) && (ltot < 1.0e30f));
        if (__syncthreads_or(bad)) return false;
    }
    const float inv = 1.f / ltot;
    LAS float* ex = (LAS float*)lds;
    if (map == 1) {
#pragma unroll
        for (int c = 0; c < 4; ++c)
#pragma unroll
            for (int i = 0; i < 16; ++i) ex[((wq * 64) + c * 16 + i) * 64 + lane] = o[c][i] * inv;
    }
    __syncthreads();
    if (map == 0) {
        float ss = 0.f;
#pragma unroll
        for (int c = 0; c < 4; ++c)
#pragma unroll
            for (int i = 0; i < 16; ++i) { const float v = o[c][i] * inv - lam * ex[((wq * 64) + c * 16 + i) * 64 + lane]; o[c][i] = v; ss += v * v; }
        ss = swap32_sum(ss);
        const float r = rsqrtf(ss * (1.f / 128.f) + EPS) * oscale;
        bf16_t* op = O + (size_t)(qrow0 + wq * 32 + r32) * D + h * 128;
#pragma unroll
        for (int c = 0; c < 4; ++c)
#pragma unroll
            for (int g4 = 0; g4 < 4; ++g4) { const int d = 32 * c + 8 * g4 + 4 * hi; const f32x4 gv = *(const f32x4*)(subln_g + d);
                u32x2 w; w.x = cvt_pk_bf16(o[c][4 * g4] * r * gv[0], o[c][4 * g4 + 1] * r * gv[1]); w.y = cvt_pk_bf16(o[c][4 * g4 + 2] * r * gv[2], o[c][4 * g4 + 3] * r * gv[3]);
                *(u32x2*)(op + d) = w; }
    }
    __syncthreads();
    return true;
}

__device__ __forceinline__ void phase_attention(const Args& a, LAS unsigned char* lds, int layer, bool ctx_queries) {
    int tid_ = threadIdx.x; asm volatile("" : "+v"(tid_)); const int G = launder_s(gridDim.x), bx = launder_s(blockIdx.x), lane = tid_ & 63;
    const int j = layer >> 1;
    const float lam_init = (layer == 0) ? 0.2f : 0.47071301f;
    const float* lp = a.in[I_LAMBDA] + j * 256;
    const float s1 = wave_sum(lp[lane] * lp[64 + lane]), s2 = wave_sum(lp[128 + lane] * lp[192 + lane]);
    const float lam = expf(s1) - expf(s2) + lam_init;
    const float oscale = 1.f - lam_init;
    const bf16_t* QKV = (const bf16_t*)(a.ws + WS_BIG); bf16_t* O = (bf16_t*)(a.ws + WS_BIG + (size_t)MALL * QKVW * 2);
    const float* sg = a.in[I_SUBLN] + j * 128;
    unsigned fail = 0u;
    constexpr int nlat = 8;
#define AT_LATENT(I, B_, H_, QB_) do { const int vcu = (bx % 8) * 32 + bx / 8; const int bh_ = (vcu >> 5) * 4 + ((I) >> 1); QB_ = ((I) & 1) * 32 + (vcu & 31); B_ = bh_ >> 3; H_ = bh_ & 7; } while (0)
    for (int i = 0; i < nlat; ++i) { int b, h, qb; AT_LATENT(i, b, h, qb); if (!attn_unit<true>(lds, QKV, O, b * SEQ + qb * 128, b, h, 132, lam, oscale, sg)) fail |= 1u << (i & 31); }
    for (int i = 0; fail != 0u; ++i, fail >>= 1) { if (fail & 1u) { int b, h, qb; AT_LATENT(i, b, h, qb); (void)attn_unit<false>(lds, QKV, O, b * SEQ + qb * 128, b, h, 132, lam, oscale, sg); } }
#undef AT_LATENT
    if (ctx_queries) { for (int idx = bx; idx < 64; idx += G) { const int bh = idx >> 1, qb = idx & 1; const int b = bh >> 3, h = bh & 7; (void)attn_unit<false>(lds, QKV, O, MLAT + b * CTX + qb * 128, b, h, 4, lam, oscale, sg); } }
}

__device__ __forceinline__ void phase_lnstats(const Args& a, int nrows) {
    int tid_ = threadIdx.x; asm volatile("" : "+v"(tid_)); const int tid = tid_, lane = tid & 63, wave = tid >> 6, G = launder_s(gridDim.x);
    const int gw = launder_s(blockIdx.x) * 8 + wave, NGW = G * 8;
    const bf16_t* Z = (const bf16_t*)(a.ws + WS_BIG); float* st = (float*)(a.ws + WS_LNST);
    for (int row0 = gw; row0 < nrows; row0 += 2 * NGW) {
        u32x4 w[2][4]; int rows[2]; rows[0] = row0; rows[1] = row0 + NGW; const bool ok1 = rows[1] < nrows; if (!ok1) rows[1] = row0;
#pragma unroll
        for (int u = 0; u < 2; ++u) { const bf16_t* zr = Z + (size_t)rows[u] * SGUW + SGUH;
#pragma unroll
            for (int j = 0; j < 4; ++j) w[u][j] = *(const u32x4*)(zr + 8 * lane + 512 * j); }
#pragma unroll
        for (int u = 0; u < 2; ++u) { if (u == 1 && !ok1) continue;
            float v[32]; float s = 0.f;
#pragma unroll
            for (int j = 0; j < 4; ++j) { const u32x4 x = w[u][j];
                v[8 * j + 0] = bf_lo(x.x); v[8 * j + 1] = bf_hi(x.x); v[8 * j + 2] = bf_lo(x.y); v[8 * j + 3] = bf_hi(x.y); v[8 * j + 4] = bf_lo(x.z); v[8 * j + 5] = bf_hi(x.z); v[8 * j + 6] = bf_lo(x.w); v[8 * j + 7] = bf_hi(x.w); }
#pragma unroll
            for (int i = 0; i < 32; ++i) s += v[i];
            const float mu = wave_sum(s) * (1.f / SGUH); float q = 0.f;
#pragma unroll
            for (int i = 0; i < 32; ++i) { const float d = v[i] - mu; q += d * d; }
            const float rstd = rsqrtf(wave_sum(q) * (1.f / SGUH) + EPS);
            if (lane == 0) { st[2 * rows[u]] = mu; st[2 * rows[u] + 1] = rstd; } }
    }
}

__device__ __forceinline__ void phase_spatial(const Args& a, LAS unsigned char* lds, int j, int nchunks) {
    int tid_ = threadIdx.x; asm volatile("" : "+v"(tid_)); const int tid = tid_, lane = tid & 63, wid = __builtin_amdgcn_readfirstlane(tid >> 6), r32 = lane & 31, hi = lane >> 5, G = launder_s(gridDim.x);
    bf16_t* Z = (bf16_t*)(a.ws + WS_BIG); const float* st = (const float*)(a.ws + WS_LNST);
    const bf16_t* wsb = (const bf16_t*)(a.ws + WS_WS) + (size_t)j * 8 * 16384;
    const float* lng = a.in[I_SLNG] + j * SGUH; const float* lnb = a.in[I_SLNB] + j * SGUH; const float* bs = a.in[I_SBS] + j * 8 * 128;
    LAS unsigned char* vt = lds;
    LAS unsigned char* wl = lds + 67584;
    int gcur = -1;
    const int lch = tid & 31, lrow = tid >> 5;
    for (int idx = launder_s(blockIdx.x); idx < nchunks * 8; idx += G) {
        const int chunk = idx >> 3, g = idx & 7; const size_t row0 = (size_t)chunk * 128;
        if (g != gcur) {
#pragma unroll
            for (int p = 0; p < 4; ++p) { const int i = tid + 512 * p; const int row = i >> 4, ch = i & 15; const u32x4 w = *(const u32x4*)(wsb + (size_t)g * 16384 + row * 128 + ch * 8);
                *(LAS u32x4*)(wl + row * 256 + ((ch ^ (row & 15)) << 4)) = w; }
            gcur = g;
        }
        {
            f32x4 g0 = *(const f32x4*)(lng + g * 256 + lch * 8), g1 = *(const f32x4*)(lng + g * 256 + lch * 8 + 4), b0 = *(const f32x4*)(lnb + g * 256 + lch * 8), b1 = *(const f32x4*)(lnb + g * 256 + lch * 8 + 4);
#pragma unroll
            for (int p = 0; p < 8; ++p) { const int row = lrow + 16 * p; const u32x4 w = *(const u32x4*)(Z + (row0 + row) * SGUW + SGUH + g * 256 + lch * 8);
                const f32x2 ms = *(const f32x2*)(st + 2 * (row0 + row));
                f32x4 x0 = {bf_lo(w.x), bf_hi(w.x), bf_lo(w.y), bf_hi(w.y)}, x1 = {bf_lo(w.z), bf_hi(w.z), bf_lo(w.w), bf_hi(w.w)};
                x0 = (x0 - ms.x) * ms.y * g0 + b0; x1 = (x1 - ms.x) * ms.y * g1 + b1;
                u32x4 o; o.x = cvt_pk_bf16(x0[0], x0[1]); o.y = cvt_pk_bf16(x0[2], x0[3]); o.z = cvt_pk_bf16(x1[0], x1[1]); o.w = cvt_pk_bf16(x1[2], x1[3]);
                *(LAS u32x4*)(vt + (lch >> 2) * 8192 + (row >> 3) * 512 + (row & 7) * 64 + (lch & 3) * 16) = o; }
        }
        __syncthreads();
        f32x16 acc[4];
#pragma unroll
        for (int pb = 0; pb < 4; ++pb)
#pragma unroll
            for (int i = 0; i < 16; ++i) acc[pb][i] = 0.f;
        const int vb = wid * 8192 + ((lane >> 4) & 1) * 32 + (lane & 3) * 8 + ((lane & 15) >> 2) * 64;
#pragma unroll
        for (int ks = 0; ks < 8; ++ks) {
            const s16x4 lo = __builtin_bit_cast(s16x4, __builtin_amdgcn_ds_read_tr16_b64_v4i16((LAS s16x4*)(vt + vb + (2 * ks + hi) * 512)));
            const s16x4 hh = __builtin_bit_cast(s16x4, __builtin_amdgcn_ds_read_tr16_b64_v4i16((LAS s16x4*)(vt + vb + (2 * ks + hi) * 512 + 256)));
            const bf16x8 vf = __builtin_shufflevector(lo, hh, 0, 1, 2, 3, 4, 5, 6, 7);
#pragma unroll
            for (int pb = 0; pb < 4; ++pb) { const int row = 32 * pb + r32; const bf16x8 wf = *(const LAS bf16x8*)(wl + row * 256 + (((2 * ks + hi) ^ (row & 15)) << 4));
                acc[pb] = __builtin_amdgcn_mfma_f32_32x32x16_bf16(vf, wf, acc[pb], 0, 0, 0); }
        }
        __syncthreads();
#pragma unroll
        for (int pb = 0; pb < 4; ++pb) { const int p = 32 * pb + r32; const float bias = bs[g * 128 + p];
#pragma unroll
            for (int g4 = 0; g4 < 4; ++g4) { u32x2 w; w.x = cvt_pk_bf16(acc[pb][4 * g4] + bias, acc[pb][4 * g4 + 1] + bias); w.y = cvt_pk_bf16(acc[pb][4 * g4 + 2] + bias, acc[pb][4 * g4 + 3] + bias);
                *(LAS u32x2*)(vt + p * 520 + (32 * wid + 8 * g4 + 4 * hi) * 2) = w; } }
        __syncthreads();
        { u32x4 uu[8];
#pragma unroll
          for (int p8 = 0; p8 < 8; ++p8) { const int row = lrow + 16 * p8; uu[p8] = *(const u32x4*)(Z + (row0 + row) * SGUW + g * 256 + lch * 8); }
#pragma unroll
          for (int p8 = 0; p8 < 8; ++p8) { const int row = lrow + 16 * p8; const u32x2 s0 = *(const LAS u32x2*)(vt + row * 520 + lch * 16), s1 = *(const LAS u32x2*)(vt + row * 520 + lch * 16 + 8);
              u32x4 o; o.x = cvt_pk_bf16(bf_lo(uu[p8].x) * bf_lo(s0.x), bf_hi(uu[p8].x) * bf_hi(s0.x)); o.y = cvt_pk_bf16(bf_lo(uu[p8].y) * bf_lo(s0.y), bf_hi(uu[p8].y) * bf_hi(s0.y));
              o.z = cvt_pk_bf16(bf_lo(uu[p8].z) * bf_lo(s1.x), bf_hi(uu[p8].z) * bf_hi(s1.x)); o.w = cvt_pk_bf16(bf_lo(uu[p8].w) * bf_lo(s1.y), bf_hi(uu[p8].w) * bf_hi(s1.y));
              *(u32x4*)(Z + (row0 + row) * SGUW + g * 256 + lch * 8) = o; } }
        __syncthreads();
    }
}

__device__ __forceinline__ void ctx_gemm(LAS unsigned char* lds, const bf16_t* A, int lda, const bf16_t* Bt, int K, bf16_t* Y) {
    int tid_ = threadIdx.x; asm volatile("" : "+v"(tid_)); const int tid = tid_, lane = tid & 63, wid = __builtin_amdgcn_readfirstlane(tid >> 6), fr = lane & 15, fq = lane >> 4;
    LAS f32x4* red = (LAS f32x4*)lds;
    const int G = launder_s(gridDim.x);
    for (int idx = launder_s(blockIdx.x); idx < 256; idx += G) {
        const int tm = idx >> 4, tn = idx & 15, kw = K >> 3;
        const bf16_t* ap = A + (size_t)(MLAT + tm * 64 + fr) * lda + wid * kw + 8 * fq;
        const bf16_t* bp = Bt + (size_t)(tn * 64 + fr) * K + wid * kw + 8 * fq;
        f32x4 acc[4][4];
#pragma unroll
        for (int i = 0; i < 4; ++i)
#pragma unroll
            for (int j = 0; j < 4; ++j) acc[i][j] = (f32x4){0.f, 0.f, 0.f, 0.f};
        for (int k0 = 0; k0 < kw; k0 += 64) {
            bf16x8 af[2][4], bf[2][4];
#pragma unroll
            for (int u = 0; u < 2; ++u)
#pragma unroll
                for (int i = 0; i < 4; ++i) { af[u][i] = *(const bf16x8*)(ap + (size_t)(16 * i) * lda + k0 + 32 * u); bf[u][i] = *(const bf16x8*)(bp + (size_t)(16 * i) * K + k0 + 32 * u); }
#pragma unroll
            for (int u = 0; u < 2; ++u)
#pragma unroll
                for (int i = 0; i < 4; ++i)
#pragma unroll
                    for (int j = 0; j < 4; ++j) acc[i][j] = __builtin_amdgcn_mfma_f32_16x16x32_bf16(bf[u][j], af[u][i], acc[i][j], 0, 0, 0);
        }
#pragma unroll
        for (int half = 4; half >= 1; half >>= 1) {
            if (wid >= half && wid < 2 * half) {
#pragma unroll
                for (int i = 0; i < 4; ++i)
#pragma unroll
                    for (int j = 0; j < 4; ++j) red[((wid - half) * 16 + i * 4 + j) * 64 + lane] = acc[i][j]; }
            __syncthreads();
            if (wid < half) {
#pragma unroll
                for (int i = 0; i < 4; ++i)
#pragma unroll
                    for (int j = 0; j < 4; ++j) acc[i][j] = acc[i][j] + red[(wid * 16 + i * 4 + j) * 64 + lane]; }
            __syncthreads();
        }
        if (wid == 0) {
#pragma unroll
            for (int i = 0; i < 4; ++i) { bf16_t* yp = Y + (size_t)(MLAT + tm * 64 + 16 * i + fr) * D + tn * 64 + 4 * fq;
#pragma unroll
                for (int j = 0; j < 4; ++j) { u32x2 w; w.x = cvt_pk_bf16(acc[i][j][0], acc[i][j][1]); w.y = cvt_pk_bf16(acc[i][j][2], acc[i][j][3]); *(u32x2*)(yp + 16 * j) = w; } }
        }
    }
}

#define XB_TMO      128
#define XB_XCNT(j)  (256  + 64 * (j))
#define XB_XSUB(j)  (1280 + 64 * (j))
#define XB_XGEN(j)  (2304 + 64 * (j))
#define XB_TOP      3328
#define XB_TOPGEN   3392
#define XCD_BAR_WORDS 3456
#define XB_SPIN_CAP (1u << 22)
__device__ __forceinline__ unsigned xb_ld(unsigned* p)              { return __hip_atomic_load(p, __ATOMIC_RELAXED, __HIP_MEMORY_SCOPE_AGENT); }
__device__ __forceinline__ unsigned xb_add(unsigned* p, unsigned v) { return __hip_atomic_fetch_add(p, v, __ATOMIC_RELAXED, __HIP_MEMORY_SCOPE_AGENT); }
__device__ __forceinline__ unsigned xb_xcc_id() { return (unsigned)__builtin_amdgcn_s_getreg((3 << 11) | 20) & 0xFu; }
#define XB_SPIN(cond, bar) do { unsigned _sp = 0; while (cond) { __builtin_amdgcn_s_sleep(1); \
    if ((++_sp & 255u) == 0u) { if (xb_ld(&(bar)[XB_TMO])) break; if (_sp > XB_SPIN_CAP) { atomicAdd(&(bar)[XB_TMO], 1u); break; } } } } while (0)
struct XcdBarrier { unsigned* bar; unsigned x; volatile LAS unsigned* st; };
__device__ __forceinline__ XcdBarrier xcd_barrier_post(unsigned* bar, volatile LAS unsigned* st) {
    XcdBarrier b; b.bar = bar; b.x = xb_xcc_id(); b.st = st;
    int t0_ = threadIdx.x; asm volatile("" : "+v"(t0_));
    if (t0_ == 0) (void)xb_add(&bar[XB_XCNT(b.x)], 1u);
    return b;
}
__device__ __forceinline__ void xcd_barrier_complete(unsigned* bar, unsigned x, unsigned& nloc, unsigned& nx) {
    const unsigned G = gridDim.x * gridDim.y * gridDim.z;
    unsigned sum, cnt, mine, sp = 0u;
    for (;;) {
        sum = 0u; cnt = 0u; mine = 0u;
#pragma unroll
        for (unsigned j = 0; j < 16; ++j) { const unsigned c = xb_ld(&bar[XB_XCNT(j)]); sum += c; cnt += (c > 0u) ? 1u : 0u; mine = (j == x) ? c : mine; }
        if (sum == G) break;
        __builtin_amdgcn_s_sleep(1);
        if ((++sp & 255u) == 0u) { if (xb_ld(&bar[XB_TMO])) break; if (sp > XB_SPIN_CAP) { atomicAdd(&bar[XB_TMO], 1u); break; } }
    }
    nloc = mine > 0u ? mine : 1u; nx = cnt > 0u ? cnt : 1u;
}
__device__ __forceinline__ void xcd_barrier(const XcdBarrier& b) {
    asm volatile("s_waitcnt vmcnt(0)" ::: "memory");
    __syncthreads();
    int t0_ = threadIdx.x; asm volatile("" : "+v"(t0_));
    if (t0_ == 0) {
        unsigned* bar = b.bar;
        __builtin_amdgcn_s_waitcnt(0);
        unsigned nloc = b.st[0], nx = b.st[1];
        if (nloc == 0u) { xcd_barrier_complete(bar, b.x, nloc, nx); b.st[0] = nloc; b.st[1] = nx; }
        const unsigned old = xb_add(&bar[XB_XSUB(b.x)], 1u);
        const unsigned gen = old / nloc;
        if (old + 1u == (gen + 1u) * nloc) {
            __builtin_amdgcn_fence(__ATOMIC_RELEASE, "agent");
            asm volatile("s_waitcnt vmcnt(0)" ::: "memory");
            const unsigned og = xb_add(&bar[XB_TOP], 1u);
            const unsigned tg = og / nx;
            if (og + 1u == (tg + 1u) * nx) xb_add(&bar[XB_TOPGEN], 1u);
            else XB_SPIN(xb_ld(&bar[XB_TOPGEN]) == tg, bar);
            __builtin_amdgcn_fence(__ATOMIC_ACQUIRE, "agent");
            xb_add(&bar[XB_XGEN(b.x)], 1u);
            asm volatile("s_waitcnt vmcnt(0)" ::: "memory");
        } else {
            XB_SPIN(xb_ld(&bar[XB_XGEN(b.x)]) == gen, bar);
            __builtin_amdgcn_fence(__ATOMIC_ACQUIRE, "agent");
            asm volatile("s_waitcnt vmcnt(0)" ::: "memory");
        }
    }
    __syncthreads();
}

constexpr int LDS_BYTES = 147456;
constexpr int NPHASES = 32;
#ifndef MK_MASK
#define MK_MASK 0xffff
#endif
#define EN(b) ((MK_MASK >> (b)) & 1)
#ifndef MK_DUP
#define MK_DUP 0
#endif
#define DUP(b) ((MK_DUP >> (b)) & 1)

__global__ void __launch_bounds__(512) fwd_megakernel(Args a) {
    extern __shared__ __attribute__((aligned(16))) unsigned char lds_raw[];
    LAS unsigned char* lds = (LAS unsigned char*)lds_raw;
    cg::grid_group grid = cg::this_grid();
    unsigned char* ws = a.ws;
    const float* mod = (const float*)(ws + WS_MOD);
    const float* normg = a.in[I_NORMG];
    bf16_t* Xbf = (bf16_t*)(ws + WS_Y);
    bf16_t* Abuf = (bf16_t*)(ws + WS_A); bf16_t* Ybuf = Abuf; bf16_t* Big = (bf16_t*)(ws + WS_BIG);
    bf16_t* Obuf = (bf16_t*)(ws + WS_BIG + (size_t)MALL * QKVW * 2);

    volatile LAS unsigned* bst = (volatile LAS unsigned*)(lds + 131072 + 1024);
    { int t0_ = threadIdx.x; asm volatile("" : "+v"(t0_)); if (t0_ == 0) { bst[0] = 0u; bst[1] = 0u; } }
    __syncthreads();
    XcdBarrier xbar; xbar.bar = (unsigned*)ws; xbar.x = 0; xbar.st = bst;
    if (a.ph_lo == 0) {
        { const int bx0 = launder_s(blockIdx.x); if (bx0 == 0) { int t0_ = threadIdx.x; asm volatile("" : "+v"(t0_)); for (int i = t0_; i < XCD_BAR_WORDS; i += 512) __hip_atomic_store((unsigned*)a.ws + i, 0u, __ATOMIC_RELAXED, __HIP_MEMORY_SCOPE_AGENT); } }
        phase_prologue(a, lds);
        if (a.ph_hi > 1) { grid.sync(); xbar = xcd_barrier_post((unsigned*)a.ws, bst); }
    }
    for (int ph = (a.ph_lo > 1 ? a.ph_lo : 1); ph < a.ph_hi; ++ph) {
        asm volatile("" : "+s"(ws));
        const int G = launder_s(gridDim.x), bxl = launder_s(blockIdx.x);
        if (ph == 0) {
            if (bxl == 0) { int t0_ = threadIdx.x; asm volatile("" : "+v"(t0_)); for (int i = t0_; i < XCD_BAR_WORDS; i += 512) __hip_atomic_store((unsigned*)a.ws + i, 0u, __ATOMIC_RELAXED, __HIP_MEMORY_SCOPE_AGENT); }
            if (EN(0)) phase_prologue(a, lds);
            if (DUP(0)) { __syncthreads(); phase_prologue(a, lds); }
        } else if (ph == 1) {
            RowPass p{}; p.xin_lat = a.in[I_X]; p.xin_ctx = a.in[I_CTX]; p.xout_lat = nullptr; p.xin_bf = nullptr; p.xout_bf = nullptr; p.Y = nullptr; p.g_post = nullptr; p.gate = nullptr;
            p.A = Abuf; p.g_pre = normg + 0 * 4096 + 0 * 1024; p.shift = mod + 0; p.scale = mod + 1024; p.nrows = MALL;
            if (EN(1)) phase_rowpass(p);
        } else {
            int layer, k;
            if (ph < 9) { layer = 0; k = ph - 2; } else if (ph < 17) { layer = 1; k = ph - 9; } else if (ph < 24) { layer = 2; k = ph - 17; } else { layer = 3; k = ph - 24; }
            const bool attn = (layer & 1) == 0; const int j = layer >> 1;
            int kind = attn ? (k == 0 ? 0 : k == 1 ? 1 : k + 1) : k;
            const bool ctx_all = layer < 2;
            const int Mfull = ctx_all ? MALL : MLAT;
            const float* lmod = mod + (size_t)layer * 5 * 6144; const float* lg = normg + layer * 4096;
            const bf16_t* cgA = nullptr; const bf16_t* cgB = nullptr; int cgLda = 0, cgK = 0;
            if (kind == 0) {
                if (attn) { pg8::Gemm g{Abuf, (const bf16_t*)(ws + WS_WQKV) + (size_t)j * QKVW * D, (layer == 2) ? MALL : Mfull, QKVW, D, D}; pg8::StaticOrder S; S.init(g.M, g.N, G, bxl);
                    pg8::EpiQKV E{Big, (const float*)(ws + WS_ROPE)}; if (EN(2)) pg8::gemm_phase<pg8::EpiQKV>(lds, g, S, E); if (DUP(2)) pg8::gemm_phase<pg8::EpiQKV>(lds, g, S, E); }
                else { pg8::Gemm g{Abuf, (const bf16_t*)(ws + WS_WIN) + (size_t)j * SGUW * D, Mfull, SGUW, D, D}; pg8::StaticOrder S; S.init(g.M, g.N, G, bxl);
                    pg8::EpiBf16<1> E{Big, SGUW, a.in[I_SBIN] + j * SGUW}; if (EN(3)) pg8::gemm_phase<pg8::EpiBf16<1>>(lds, g, S, E); if (DUP(3)) pg8::gemm_phase<pg8::EpiBf16<1>>(lds, g, S, E); }
            } else if (kind == 1) {
                if (attn) { if (EN(6)) phase_attention(a, lds, layer, layer == 0); if (DUP(6)) { __syncthreads(); phase_attention(a, lds, layer, layer == 0); } }
                else { if (EN(7)) phase_lnstats(a, Mfull); }
            } else if (kind == 2) {
                if (EN(8)) phase_spatial(a, lds, j, Mfull / 128);
            } else if (kind == 3) {
                if (attn) { pg8::Gemm g{Obuf, (const bf16_t*)(ws + WS_WO) + (size_t)j * D * D, MLAT, D, D, D}; pg8::StaticOrder S; S.init(g.M, g.N, G, bxl);
                    pg8::EpiBf16<0> E{Ybuf, D, nullptr}; if (EN(4)) pg8::gemm_phase<pg8::EpiBf16<0>>(lds, g, S, E); if (DUP(4)) pg8::gemm_phase<pg8::EpiBf16<0>>(lds, g, S, E); }
                else { pg8::Gemm g{Big, (const bf16_t*)(ws + WS_WOUT) + (size_t)j * D * SGUH, MLAT, D, SGUH, SGUW}; pg8::StaticOrder S; S.init(g.M, g.N, G, bxl);
                    pg8::EpiBf16<0> E{Ybuf, D, nullptr}; if (EN(4)) pg8::gemm_phase<pg8::EpiBf16<0>>(lds, g, S, E); if (DUP(4)) pg8::gemm_phase<pg8::EpiBf16<0>>(lds, g, S, E); }
                if (ctx_all) {
                    if (attn) { cgA = Obuf; cgLda = D; cgB = (const bf16_t*)(ws + WS_WO) + (size_t)j * D * D; cgK = D; }
                    else { cgA = Big; cgLda = SGUW; cgB = (const bf16_t*)(ws + WS_WOUT) + (size_t)j * D * SGUH; cgK = SGUH; } }
            } else if (kind == 4) {
                RowPass p{}; const bool first = (layer == 0);
                p.xin_lat = a.in[I_X]; p.xin_ctx = a.in[I_CTX]; p.xin_bf = first ? nullptr : Xbf; p.xout_lat = nullptr; p.xout_bf = Xbf;
                p.Y = Ybuf; p.g_post = lg + 1024; p.gate = lmod + 2 * 1024;
                p.A = Abuf; p.g_pre = lg + 2048; p.shift = lmod + 3 * 1024; p.scale = lmod + 4 * 1024; p.nrows = Mfull;
                if (EN(1)) phase_rowpass(p);
            } else if (kind == 5) {
                pg8::Gemm g{Abuf, (const bf16_t*)(ws + WS_W1) + (size_t)layer * FF * D, Mfull, FF, D, D}; pg8::StaticOrder S; S.init(g.M, g.N, G, bxl);
                pg8::EpiBf16<2> E{Big, FF, nullptr}; if (EN(5)) pg8::gemm_phase<pg8::EpiBf16<2>>(lds, g, S, E); if (DUP(5)) pg8::gemm_phase<pg8::EpiBf16<2>>(lds, g, S, E);
            } else if (kind == 6) {
                pg8::Gemm g{Big, (const bf16_t*)(ws + WS_W2) + (size_t)layer * D * FF, MLAT, D, FF, FF}; pg8::StaticOrder S; S.init(g.M, g.N, G, bxl);
                pg8::EpiBf16<0> E{Ybuf, D, nullptr}; if (EN(4)) pg8::gemm_phase<pg8::EpiBf16<0>>(lds, g, S, E); if (DUP(4)) pg8::gemm_phase<pg8::EpiBf16<0>>(lds, g, S, E);
                if (ctx_all) { cgA = Big; cgLda = FF; cgB = (const bf16_t*)(ws + WS_W2) + (size_t)layer * D * FF; cgK = FF; }
            } else {
                RowPass p{}; p.xin_lat = nullptr; p.xin_ctx = nullptr; p.xin_bf = Xbf; p.xout_lat = (layer == 3) ? a.out : nullptr; p.xout_bf = (layer == 3) ? nullptr : Xbf;
                p.Y = Ybuf; p.g_post = lg + 3072; p.gate = lmod + 5 * 1024;
                if (layer < 3) { const float* nmod = mod + (size_t)(layer + 1) * 5 * 6144; p.A = Abuf; p.g_pre = normg + (layer + 1) * 4096; p.shift = nmod; p.scale = nmod + 1024; }
                else { p.A = nullptr; p.g_pre = nullptr; p.shift = nullptr; p.scale = nullptr; }
                p.nrows = (layer == 1) ? MALL : Mfull;
                if (EN(1)) phase_rowpass(p);
            }
            if (cgK) ctx_gemm(lds, cgA, cgLda, cgB, cgK, Ybuf);
        }
        if (ph + 1 < a.ph_hi) {
            xcd_barrier(xbar);
        }
    }
}

#ifndef MK_PER_PHASE
#define MK_PER_PHASE 0
#endif
extern "C" void kernel_launch(void* const* d_in, const int* in_sizes, int n_in, void* d_out, int out_size, void* d_ws, size_t ws_size, hipStream_t stream) {
    static int grid = 0;
    if (grid == 0) {
        if (n_in != 20 || in_sizes[0] != MLAT * D || out_size != MLAT * D || ws_size < WS_END) {
            fprintf(stderr, "kernel_launch: unexpected shapes: n_in %d in0 %d out %d ws %zu (need %zu)\n", n_in, n_in > 0 ? in_sizes[0] : -1, out_size, ws_size, (size_t)WS_END); grid = -1; return; }
        int dev = 0, cus = 0, per_cu = 0;
        hipGetDevice(&dev); hipDeviceGetAttribute(&cus, hipDeviceAttributeMultiprocessorCount, dev);
        if (hipFuncSetAttribute((const void*)fwd_megakernel, hipFuncAttributeMaxDynamicSharedMemorySize, LDS_BYTES) != hipSuccess) { fprintf(stderr, "kernel_launch: hipFuncSetAttribute failed\n"); grid = -1; return; }
        if (hipOccupancyMaxActiveBlocksPerMultiprocessor(&per_cu, (const void*)fwd_megakernel, 512, LDS_BYTES) != hipSuccess || per_cu < 1) { fprintf(stderr, "kernel_launch: occupancy query says %d\n", per_cu); per_cu = 1; }
        (void)hipGetLastError();
        grid = cus * (per_cu > 1 ? 1 : per_cu);
        fprintf(stderr, "kernel_launch: grid %d (cus %d, per_cu %d)\n", grid, cus, per_cu);
        if (grid != 256) { fprintf(stderr, "kernel_launch: this build needs exactly 256 workgroups (one per CU); nothing launched\n"); grid = -1; return; }
    }
    if (grid < 0) return;
    Args a{};
    for (int i = 0; i < 20; ++i) a.in[i] = (const float*)d_in[i];
    a.out = (float*)d_out; a.ws = (unsigned char*)d_ws;
#if MK_PER_PHASE
    for (int ph = 0; ph < NPHASES; ++ph) { a.ph_lo = ph; a.ph_hi = ph + 1; hipLaunchKernelGGL(fwd_megakernel, dim3(grid), dim3(512), LDS_BYTES, stream, a); }
#else
    a.ph_lo = 0; a.ph_hi = NPHASES;
    void* args[] = {&a};
    hipError_t e = hipLaunchCooperativeKernel((const void*)fwd_megakernel, dim3(grid), dim3(512), args, LDS_BYTES, stream);
    if (e != hipSuccess) fprintf(stderr, "kernel_launch: cooperative launch failed: %s (grid %d)\n", hipGetErrorString(e), grid);
#endif
}
```
